# Optimizing an MI355X kernel written in HIP

```python
import jax, jax.numpy as jnp
from jax import lax
import numpy as np

D_MODEL = 1024
BATCH = 8
SEQ = 2048
DEPTH = 4

N_META = 16
BLOCK = 128
N_PAD = BLOCK - N_META
EPS = 1e-6
N_BRANCH = 4
SB_DIM = 64
SB_HEADS = D_MODEL // 128
SB_W = SB_HEADS * SB_DIM
RET_QK = 64
RET_V = 128
RET_HEADS = D_MODEL // 256
RET_QK_W = RET_HEADS * RET_QK
RET_V_W = RET_HEADS * RET_V
RW_DIM = 64
RW_HEADS = D_MODEL // 128
RW_W = RW_HEADS * RW_DIM
RW_W_LORA = 64
RW_A_LORA = 64
RW_V_LORA = 32
RW_G_LORA = 128
RW_IN = 3 * RW_W + RW_W_LORA + RW_A_LORA + RW_G_LORA
RW_LN_EPS = 64e-5
SW_DIM = 64
SW_QH = D_MODEL // 128
SW_KVH = SW_QH // 4
SW_G = SW_QH // SW_KVH
SW_Q_W = SW_QH * SW_DIM
SW_KV_W = SW_KVH * SW_DIM
WINDOW = 128
D_FF = 4 * D_MODEL
IN_SIZES = (SB_W, SB_W, SB_W,
            RET_QK_W, RET_QK_W, RET_V_W, RET_V_W,
            RW_IN,
            SW_Q_W, SW_KV_W, SW_KV_W,
            N_BRANCH * D_MODEL)
N_IN = 3 * SB_W + 2 * RET_QK_W + 2 * RET_V_W + RW_IN + SW_Q_W + 2 * SW_KV_W + N_BRANCH * D_MODEL

kernel_name = 'hybrid_gated_four_mixer_block'


def _split(z, sizes):
    return jnp.split(z, np.cumsum(np.array(sizes))[:-1].tolist(), axis=-1)


def _rms(x, g=None, eps=EPS):
    xf = x.astype(jnp.float32)
    y = xf * lax.rsqrt(jnp.mean(xf * xf, axis=-1, keepdims=True) + eps)
    if g is not None:
        y = y * g.astype(jnp.float32)
    return y


def stick_breaking_attention(q, k, v, valid):
    B, L, H, Dh = q.shape
    nb = L // BLOCK
    scale = Dh ** -0.5
    qb = q.reshape(B, nb, BLOCK, H, Dh).transpose(1, 0, 3, 2, 4)
    kpos = jnp.arange(L)

    def one_block(args):
        qblk, b = args
        z = jnp.einsum('bhqd,bkhd->bhqk', qblk, k).astype(jnp.float32) * scale
        qpos = b * BLOCK + jnp.arange(BLOCK)
        allowed = (kpos[None, :] < qpos[:, None]) & valid[None, :]
        log_1mb = jnp.where(allowed, jax.nn.log_sigmoid(-z), 0.0)
        after = lax.cumsum(log_1mb, axis=3, reverse=True) - log_1mb
        log_a = jax.nn.log_sigmoid(z) + after
        a = jnp.where(allowed, jnp.exp(log_a), 0.0)
        return jnp.einsum('bhqk,bkhd->bqhd', a.astype(v.dtype), v)

    out = lax.map(one_block, (qb, jnp.arange(nb)))
    return out.transpose(1, 0, 2, 3, 4).reshape(B, L, H * Dh)


def retention(q, k, v):
    B, L, H, dk = q.shape
    dv = v.shape[-1]
    nc = L // BLOCK
    f32 = jnp.float32
    log_g = jnp.log(1.0 - 2.0 ** (-5.0 - jnp.arange(H, dtype=f32)))
    qc = q.astype(f32).reshape(B, nc, BLOCK, H, dk)
    kc = (k.astype(f32) * dk ** -0.5).reshape(B, nc, BLOCK, H, dk)
    vc = v.astype(f32).reshape(B, nc, BLOCK, H, dv)
    idx = jnp.arange(BLOCK, dtype=f32)
    diff = idx[:, None] - idx[None, :]
    dmask = jnp.where(diff >= 0, jnp.exp(log_g[:, None, None] * jnp.maximum(diff, 0.0)), 0.0)
    scores = jnp.einsum('bcihd,bcjhd->bchij', qc, kc) * dmask
    o_intra = jnp.einsum('bchij,bcjhe->bcihe', scores, vc)
    k_dec = kc * jnp.exp((BLOCK - 1 - idx)[:, None] * log_g[None, :])[:, :, None]
    kv = jnp.einsum('bcjhd,bcjhe->cbhde', k_dec, vc)
    chunk_decay = jnp.exp(log_g * BLOCK)[None, :, None, None]

    def step(S, kv_c):
        return S * chunk_decay + kv_c, S

    _, s_prev = lax.scan(step, jnp.zeros((B, H, dk, dv), f32), kv)
    q_dec = qc * jnp.exp((idx + 1.0)[:, None] * log_g[None, :])[:, :, None]
    o = o_intra + jnp.einsum('bcihd,cbhde->bcihe', q_dec, s_prev)
    o = _rms(o)
    return o.reshape(B, L, H * dv)


def rwkv7_project(c_in, mu, w0, w2, a0, a2, g2, k_k, k_a):
    B, L, _ = c_in.shape
    prev = jnp.pad(c_in, ((0, 0), (1, 0), (0, 0)))[:, :-1]
    c = c_in + (prev - c_in) * mu
    r, k, v, w_d, a_d, g_d = _split(c, (RW_W, RW_W, RW_W, RW_W_LORA, RW_A_LORA, RW_G_LORA))
    w = -jax.nn.softplus(-(w0 + jnp.tanh(w_d) @ w2)) - 0.5
    decay = jnp.exp(-jnp.exp(w.astype(jnp.float32)))
    a = jax.nn.sigmoid(a0 + a_d @ a2)
    g = jax.nn.sigmoid(g_d) @ g2
    kk = (k * k_k).reshape(B, L, RW_HEADS, RW_DIM).astype(jnp.float32)
    kk = kk / jnp.maximum(jnp.linalg.norm(kk, axis=-1, keepdims=True), 1e-12)
    kk = kk.reshape(B, L, RW_W)
    k = k * (1.0 + (a - 1.0) * k_a)
    return r, decay, k, v, kk, a, g


def rwkv7_mix(r, decay, k, v, kk, a, g, r_k, ln_g, ln_b):
    B, L, C = r.shape
    f32 = jnp.float32

    def hd(t):
        return t.reshape(B, L, RW_HEADS, RW_DIM).astype(f32)

    r_, w_, k_, v_, kk_, a_ = hd(r), hd(decay), hd(k), hd(v), hd(kk), hd(a)
    b_ = kk_ * a_

    def step(S, inp):
        r_t, w_t, k_t, v_t, kk_t, b_t = inp
        S = (S * w_t[:, :, None, :]
             - jnp.einsum('bhij,bhj->bhi', S, kk_t)[..., None] * b_t[:, :, None, :]
             + v_t[..., None] * k_t[:, :, None, :])
        return S, jnp.einsum('bhij,bhj->bhi', S, r_t)

    xs = tuple(t.transpose(1, 0, 2, 3) for t in (r_, w_, k_, v_, kk_, b_))
    _, y = lax.scan(step, jnp.zeros((B, RW_HEADS, RW_DIM, RW_DIM), f32), xs)
    y = y.transpose(1, 0, 2, 3)
    mean = jnp.mean(y, axis=-1, keepdims=True)
    var = jnp.mean(jnp.square(y - mean), axis=-1, keepdims=True)
    y = ((y - mean) * lax.rsqrt(var + RW_LN_EPS)).reshape(B, L, C) * ln_g + ln_b
    bonus = jnp.sum(r_ * k_ * r_k, axis=-1, keepdims=True) * v_
    y = y + bonus.reshape(B, L, C)
    return y * g


def sliding_window_attention(q, k, v, qn_g, kn_g, sink):
    B, L, _ = q.shape
    nb = L // BLOCK
    f32 = jnp.float32
    q = _rms(q.reshape(B, L, SW_KVH, SW_G, SW_DIM), qn_g)
    k = _rms(k.reshape(B, L, SW_KVH, SW_DIM), kn_g)
    v = v.reshape(B, L, SW_KVH, SW_DIM).astype(f32)
    scale = SW_DIM ** -0.5
    qb = q.reshape(B, nb, BLOCK, SW_KVH, SW_G, SW_DIM)

    def band(t):
        tb = t.reshape(B, nb, BLOCK, SW_KVH, SW_DIM)
        prev = jnp.pad(tb, ((0, 0), (1, 0), (0, 0), (0, 0), (0, 0)))[:, :-1]
        return jnp.concatenate([prev, tb], axis=2)

    kband, vband = band(k), band(v)
    k_meta, v_meta = k[:, N_PAD:BLOCK], v[:, N_PAD:BLOCK]
    qpos = jnp.arange(nb)[:, None] * BLOCK + jnp.arange(BLOCK)[None, :]
    kpos = jnp.arange(nb)[:, None] * BLOCK - BLOCK + jnp.arange(2 * BLOCK)[None, :]
    dist = qpos[:, :, None] - kpos[:, None, :]
    band_ok = (dist >= 0) & (dist < WINDOW) & (kpos[:, None, :] >= BLOCK)
    meta_ok = (N_PAD + jnp.arange(N_META))[None, None, :] <= qpos[:, :, None]
    slopes = (2.0 ** (-8.0 * jnp.arange(1, SW_QH + 1, dtype=f32) / SW_QH)).reshape(SW_KVH, SW_G)
    s_band = (jnp.einsum('bnqhgd,bnkhd->bnhgqk', qb, kband) * scale
              - slopes[:, :, None, None] * dist[:, None, None].astype(f32))
    s_band = jnp.where(band_ok[:, None, None], s_band, -jnp.inf)
    s_meta = jnp.einsum('bnqhgd,bmhd->bnhgqm', qb, k_meta) * scale
    s_meta = jnp.where(meta_ok[:, None, None], s_meta, -jnp.inf)
    sink_logit = jnp.broadcast_to(sink.reshape(SW_KVH, SW_G).astype(f32)[None, None, :, :, None, None],
                                  (B, nb, SW_KVH, SW_G, BLOCK, 1))
    p = jax.nn.softmax(jnp.concatenate([s_meta, s_band, sink_logit], axis=-1), axis=-1)
    o = (jnp.einsum('bnhgqm,bmhd->bnqhgd', p[..., :N_META], v_meta)
         + jnp.einsum('bnhgqk,bnkhd->bnqhgd', p[..., N_META:N_META + 2 * BLOCK], vband))
    return o.reshape(B, L, SW_Q_W)


def squared_relu_mlp(h, w_up, w_down):
    u = jax.nn.relu(h @ w_up)
    return (u * u) @ w_down


def setup_inputs(seed: int = 0) -> dict:
    key = jax.random.key(seed)
    keys = list(jax.random.split(key, 40))
    f32 = jnp.float32
    D = D_MODEL

    def nrm(shape, scale):
        return jax.random.normal(keys.pop(), shape, f32) * scale

    def gain(shape):
        return 1.0 + nrm(shape, 0.05)

    return {
        'x': nrm((BATCH, SEQ, D), 1.0),
        'meta': nrm((N_META, D), 1.0),
        'norm1_g': gain((DEPTH, D)),
        'w_in': nrm((DEPTH, D, N_IN), D ** -0.5),
        'rw_mu': jax.random.uniform(keys.pop(), (DEPTH, RW_IN), f32),
        'rw_w0': jax.random.uniform(keys.pop(), (DEPTH, RW_W), f32, -6.0, -1.0),
        'rw_w2': nrm((DEPTH, RW_W_LORA, RW_W), 0.5 * RW_W_LORA ** -0.5),
        'rw_a0': nrm((DEPTH, RW_W), 0.5),
        'rw_a2': nrm((DEPTH, RW_A_LORA, RW_W), 0.5 * RW_A_LORA ** -0.5),
        'rw_g2': nrm((DEPTH, RW_G_LORA, RW_W), RW_G_LORA ** -0.5),
        'rw_kk': 1.0 + nrm((DEPTH, RW_W), 0.1),
        'rw_ka': 1.0 + nrm((DEPTH, RW_W), 0.1),
        'rw_rk': nrm((DEPTH, RW_HEADS, RW_DIM), 0.1),
        'rw_ln_g': gain((DEPTH, RW_W)),
        'rw_ln_b': nrm((DEPTH, RW_W), 0.02),
        'rw_v0': nrm((DEPTH - 1, RW_W), 0.5),
        'rw_v1': nrm((DEPTH - 1, D, RW_V_LORA), D ** -0.5),
        'rw_v2': nrm((DEPTH - 1, RW_V_LORA, RW_W), 0.5 * RW_V_LORA ** -0.5),
        'sw_qn_g': gain((DEPTH, SW_DIM)),
        'sw_kn_g': gain((DEPTH, SW_DIM)),
        'sw_sink': nrm((DEPTH, SW_QH), 0.5),
        'p_sb': nrm((DEPTH, SB_W, D), SB_W ** -0.5),
        'p_ret': nrm((DEPTH, RET_V_W, D), RET_V_W ** -0.5),
        'p_rw': nrm((DEPTH, RW_W, D), RW_W ** -0.5),
        'p_sw': nrm((DEPTH, SW_Q_W, D), SW_Q_W ** -0.5),
        'w_o': nrm((DEPTH, D, D), D ** -0.5),
        'norm2_g': gain((DEPTH, D)),
        'w_up': nrm((DEPTH, D, D_FF), D ** -0.5),
        'w_down': nrm((DEPTH, D_FF, D), 0.5 * D_FF ** -0.5),
    }


def reference(x, meta, norm1_g, w_in, rw_mu, rw_w0, rw_w2, rw_a0, rw_a2, rw_g2,
              rw_kk, rw_ka, rw_rk, rw_ln_g, rw_ln_b, rw_v0, rw_v1, rw_v2,
              sw_qn_g, sw_kn_g, sw_sink, p_sb, p_ret, p_rw, p_sw, w_o,
              norm2_g, w_up, w_down):
    B = x.shape[0]
    dt = x.dtype
    pad = jnp.zeros((B, N_PAD, D_MODEL), dt)
    metas = jnp.broadcast_to(meta.astype(dt)[None], (B, N_META, D_MODEL))
    x = jnp.concatenate([pad, metas, x], axis=1)
    L = x.shape[1]
    valid_b = jnp.arange(L) >= N_PAD
    valid = valid_b[None, :, None].astype(dt)
    v_first = None
    for l in range(DEPTH):
        h = (_rms(x, norm1_g[l]) * valid).astype(dt)
        z = h @ w_in[l]
        aq, ak, av, bq, bk, bv, bg, c_in, dq, dk, dv, gz = _split(z, IN_SIZES)
        y_sb = stick_breaking_attention(aq.reshape(B, L, SB_HEADS, SB_DIM),
                                        ak.reshape(B, L, SB_HEADS, SB_DIM),
                                        av.reshape(B, L, SB_HEADS, SB_DIM), valid_b)
        y_ret = jax.nn.silu(bg.astype(jnp.float32)) * retention(
            bq.reshape(B, L, RET_HEADS, RET_QK), bk.reshape(B, L, RET_HEADS, RET_QK),
            bv.reshape(B, L, RET_HEADS, RET_V))
        r, decay, k, v, kk, a, g = rwkv7_project(c_in, rw_mu[l], rw_w0[l], rw_w2[l], rw_a0[l],
                                                 rw_a2[l], rw_g2[l], rw_kk[l], rw_ka[l])
        if l == 0:
            v_first = v
        else:
            v = v + (v_first - v) * jax.nn.sigmoid(rw_v0[l - 1] + (h @ rw_v1[l - 1]) @ rw_v2[l - 1])
        y_rw = rwkv7_mix(r, decay, k, v, kk, a, g, rw_rk[l], rw_ln_g[l], rw_ln_b[l])
        y_sw = sliding_window_attention(dq, dk, dv, sw_qn_g[l], sw_kn_g[l], sw_sink[l])
        gates = jax.nn.sigmoid(gz.astype(jnp.float32)).reshape(B, L, N_BRANCH, D_MODEL)
        merged = (gates[:, :, 0] * (y_sb.astype(dt) @ p_sb[l])
                  + gates[:, :, 1] * (y_ret.astype(dt) @ p_ret[l])
                  + gates[:, :, 2] * (y_rw.astype(dt) @ p_rw[l])
                  + gates[:, :, 3] * (y_sw.astype(dt) @ p_sw[l]))
        x = x + (merged.astype(dt) @ w_o[l]).astype(dt)
        h2 = _rms(x, norm2_g[l]).astype(dt)
        x = x + squared_relu_mlp(h2, w_up[l], w_down[l]).astype(dt)
    return x[:, BLOCK:]
```

```cpp
#include <hip/hip_runtime.h>
#include <hip/hip_cooperative_groups.h>
#include <cstdio>
namespace cg = cooperative_groups;

typedef unsigned short bf16_t;
typedef short bf16x8 __attribute__((ext_vector_type(8)));
typedef float f32x16 __attribute__((ext_vector_type(16)));
typedef float f32x4 __attribute__((ext_vector_type(4)));
typedef unsigned u32x2 __attribute__((ext_vector_type(2)));
typedef unsigned u32x4 __attribute__((ext_vector_type(4)));

#define DEVINL __device__ __forceinline__
#define MFMA32(a, b, c) __builtin_amdgcn_mfma_f32_32x32x16_bf16((a), (b), (c), 0, 0, 0)

constexpr int NB = 8, SEQ = 2048, L = 2176, T = NB * L, DM = 1024, DEPTH = 4;
constexpr int NZP = 9856, ZW = 8704, DFF = 4096;
constexpr int NTHR = 512;
#define MULTI_LAUNCH 0
constexpr int Z_AQ = 0, Z_AK = 512, Z_BQ = 1024, Z_BK = 1280, Z_BG = 1536, Z_C = 2048, Z_DQ = 3840, Z_DK = 4352, Z_GZ = 4480, Z_VL = 8576;
constexpr float LOG2E = 1.4426950408889634f;
constexpr float QS = 0.125f * LOG2E;

enum { I_X = 0, I_META, I_N1G, I_WIN, I_MU, I_W0, I_W2, I_A0, I_A2, I_G2, I_KKW, I_KAW, I_RK, I_LNG, I_LNB, I_V0, I_V1, I_V2,
       I_QNG, I_KNG, I_SINK, I_PSB, I_PRET, I_PRW, I_PSW, I_WO, I_N2G, I_WUP, I_WDN, N_INPUTS };

constexpr size_t SZ_WIN = (size_t)NZP * DM * 2, SZ_PBR = (size_t)4 * DM * 512 * 2, SZ_WO = (size_t)DM * DM * 2, SZ_WUP = (size_t)DFF * DM * 2, SZ_WDN = SZ_WUP;
constexpr size_t SZ_Z = (size_t)T * ZW * 2, SZ_A512 = (size_t)T * 512 * 2;
constexpr size_t OFF_WIN = 0, OFF_PBR = OFF_WIN + SZ_WIN, OFF_WO = OFF_PBR + SZ_PBR, OFF_WUP = OFF_WO + SZ_WO, OFF_WDN = OFF_WUP + SZ_WUP,
                 OFF_Z = OFF_WDN + SZ_WDN, OFF_AVT = OFF_Z + SZ_Z, OFF_BVT = OFF_AVT + SZ_A512, OFF_DVT = OFF_BVT + SZ_A512,
                 OFF_BKT = OFF_DVT + (size_t)T * 128 * 2, OFF_RW = OFF_BKT + (size_t)T * 256 * 2, OFF_Y = OFF_RW + 7 * SZ_A512,
                 OFF_VF = OFF_Y + 4 * SZ_A512, OFF_XL = OFF_VF + SZ_A512, WS_END = OFF_XL + (size_t)NB * 128 * DM * 4;

struct Params {
    const float* in[N_INPUTS];
    float* out;
    unsigned char* ws;
    int ph_lo, ph_hi;
};

struct Ctx {
    const float* const* in;
    unsigned char* ws;
    float* out;
    DEVINL bf16_t* Win() const { return (bf16_t*)(ws + OFF_WIN); }
    DEVINL bf16_t* Pbr() const { return (bf16_t*)(ws + OFF_PBR); }
    DEVINL bf16_t* Wo() const { return (bf16_t*)(ws + OFF_WO); }
    DEVINL bf16_t* Wup() const { return (bf16_t*)(ws + OFF_WUP); }
    DEVINL bf16_t* Wdn() const { return (bf16_t*)(ws + OFF_WDN); }
    DEVINL bf16_t* Z() const { return (bf16_t*)(ws + OFF_Z); }
    DEVINL bf16_t* U() const { return (bf16_t*)(ws + OFF_Z); }
    DEVINL bf16_t* AVT() const { return (bf16_t*)(ws + OFF_AVT); }
    DEVINL bf16_t* BVT() const { return (bf16_t*)(ws + OFF_BVT); }
    DEVINL bf16_t* DVT() const { return (bf16_t*)(ws + OFF_DVT); }
    DEVINL bf16_t* BKT() const { return (bf16_t*)(ws + OFF_BKT); }
    DEVINL bf16_t* RW() const { return (bf16_t*)(ws + OFF_RW); }
    DEVINL bf16_t* H() const { return (bf16_t*)(ws + OFF_RW); }
    DEVINL bf16_t* M() const { return (bf16_t*)(ws + OFF_RW + 2 * SZ_A512); }
    DEVINL bf16_t* Y() const { return (bf16_t*)(ws + OFF_Y); }
    DEVINL bf16_t* VF() const { return (bf16_t*)(ws + OFF_VF); }
    DEVINL float* xlead() const { return (float*)(ws + OFF_XL); }
};

DEVINL int opq_v(int x) { asm volatile("" : "+v"(x)); return x; }
DEVINL int opq_s(int x) { asm volatile("" : "+s"(x)); return x; }
#define TID (opq_v((int)threadIdx.x))
#define BID (opq_s((int)blockIdx.x))
typedef float f32x2 __attribute__((ext_vector_type(2)));
typedef __bf16 bf16x2v __attribute__((ext_vector_type(2)));
DEVINL unsigned cvt_pk_bf16(float lo, float hi) { const f32x2 v = {lo, hi}; return __builtin_bit_cast(unsigned, __builtin_convertvector(v, bf16x2v)); }
DEVINL bf16_t f2bf(float f) { return (bf16_t)(cvt_pk_bf16(f, 0.f) & 0xffffu); }
DEVINL float bf2f(bf16_t v) { return __uint_as_float(((unsigned)v) << 16); }
DEVINL float bflo(unsigned u) { return __uint_as_float(u << 16); }
DEVINL float bfhi(unsigned u) { return __uint_as_float(u & 0xffff0000u); }
DEVINL float fexp2(float x) { return __builtin_amdgcn_exp2f(x); }
DEVINL float flog2(float x) { return __builtin_amdgcn_logf(x); }
DEVINL float sigmoidf_(float x) { return __builtin_amdgcn_rcpf(1.f + fexp2(-x * LOG2E)); }
DEVINL float wave_sum(float v) {
#pragma unroll
    for (int o = 32; o >= 1; o >>= 1) v += __shfl_xor(v, o);
    return v;
}
#define DPPF(v, ctrl) __int_as_float(__builtin_amdgcn_update_dpp(0, __float_as_int(v), (ctrl), 0xF, 0xF, true))
DEVINL float wave_sum_dpp(float v) {
    v += DPPF(v, 0xB1); v += DPPF(v, 0x4E); v += DPPF(v, 0x141); v += DPPF(v, 0x140);
    const int iv = __float_as_int(v);
    return (__int_as_float(__builtin_amdgcn_readlane(iv, 0)) + __int_as_float(__builtin_amdgcn_readlane(iv, 16))) +
           (__int_as_float(__builtin_amdgcn_readlane(iv, 32)) + __int_as_float(__builtin_amdgcn_readlane(iv, 48)));
}
DEVINL float quad_sum(float v) {
    v += __int_as_float(__builtin_amdgcn_update_dpp(0, __float_as_int(v), 0xB1, 0xF, 0xF, true));
    v += __int_as_float(__builtin_amdgcn_update_dpp(0, __float_as_int(v), 0x4E, 0xF, 0xF, true));
    return v;
}
DEVINL float* xrow(const Ctx& c, int t) {
    const int b = t / L, p = t - b * L;
    return p < 128 ? c.xlead() + (size_t)(b * 128 + p) * DM : c.out + ((size_t)b * SEQ + (p - 128)) * DM;
}
DEVINL int slot_of_block() {
    const int G = gridDim.x, bx = BID;
    return (G % 8 == 0) ? (bx % 8) * (G / 8) + bx / 8 : bx;
}
#ifndef TILE_GW
#define TILE_GW 8
#endif
DEVINL void tile_of(int q, int MT, int NT, int& m, int& n) {
    const int per = MT * TILE_GW, ng = q / per, rem = q - ng * per;
    int nw = NT - ng * TILE_GW; nw = nw > TILE_GW ? TILE_GW : nw;
    m = rem / nw; n = ng * TILE_GW + rem % nw;
}

DEVINL void phase_init(const Ctx& c) {
    const float* x = c.in[I_X]; const float* meta = c.in[I_META];
    const int total = T * (DM / 4);
    for (int idx = BID * NTHR + TID; idx < total; idx += gridDim.x * NTHR) {
        const int t = idx >> 8, c4 = (idx & 255) * 4;
        const int b = t / L, p = t - b * L;
        f32x4 v = {0.f, 0.f, 0.f, 0.f};
        if (p >= 128) v = *(const f32x4*)(x + ((size_t)b * SEQ + (p - 128)) * DM + c4);
        else if (p >= 112) v = *(const f32x4*)(meta + (size_t)(p - 112) * DM + c4);
        *(f32x4*)(xrow(c, t) + c4) = v;
    }
}

DEVINL void cvt_mat(const float* __restrict__ src, int K, int N, bf16_t* __restrict__ dst, float* lds) {
    const int kt = K / 64, ntl = (N + 63) / 64, total = kt * ntl;
    const int tid = TID, G = gridDim.x;
    float v[8];
    int tile = BID;
    if (tile < total) {
        const int k0 = (tile / ntl) * 64, n0 = (tile % ntl) * 64;
#pragma unroll
        for (int i = 0; i < 8; ++i) { const int e = tid + i * NTHR, k = e >> 6, n = e & 63; v[i] = (n0 + n < N) ? src[(size_t)(k0 + k) * N + n0 + n] : 0.f; }
    }
    for (; tile < total; tile += G) {
        const int k0 = (tile / ntl) * 64, n0 = (tile % ntl) * 64;
        __syncthreads();
#pragma unroll
        for (int i = 0; i < 8; ++i) { const int e = tid + i * NTHR; lds[(e >> 6) * 65 + (e & 63)] = v[i]; }
        __syncthreads();
        if (tile + G < total) {
            const int t2 = tile + G, k2 = (t2 / ntl) * 64, n2 = (t2 % ntl) * 64;
#pragma unroll
            for (int i = 0; i < 8; ++i) { const int e = tid + i * NTHR, k = e >> 6, n = e & 63; v[i] = (n2 + n < N) ? src[(size_t)(k2 + k) * N + n2 + n] : 0.f; }
        }
        for (int e = tid; e < 2048; e += NTHR) {
            const int n = e >> 5, kk = (e & 31) * 2;
            if (n0 + n < N) *(unsigned*)(dst + (size_t)(n0 + n) * K + k0 + kk) = cvt_pk_bf16(lds[kk * 65 + n], lds[(kk + 1) * 65 + n]);
        }
    }
}
DEVINL void phase_cvt(const Ctx& c, int l, float* lds) {
    cvt_mat(c.in[I_WIN] + (size_t)l * DM * 9728, DM, 9728, c.Win(), lds);
    if (l > 0) cvt_mat(c.in[I_V1] + (size_t)(l - 1) * DM * 32, DM, 32, c.Win() + (size_t)9728 * DM, lds);
    {
        const int r0 = 9728 + (l > 0 ? 32 : 0), n = (NZP - r0) * DM / 8;
        u32x4 z = {0u, 0u, 0u, 0u};
        for (int i = BID * NTHR + TID; i < n; i += gridDim.x * NTHR) *(u32x4*)(c.Win() + (size_t)r0 * DM + (size_t)i * 8) = z;
    }
    cvt_mat(c.in[I_PSB] + (size_t)l * 512 * DM, 512, DM, c.Pbr(), lds);
    cvt_mat(c.in[I_PRET] + (size_t)l * 512 * DM, 512, DM, c.Pbr() + (size_t)DM * 512, lds);
    cvt_mat(c.in[I_PRW] + (size_t)l * 512 * DM, 512, DM, c.Pbr() + (size_t)2 * DM * 512, lds);
    cvt_mat(c.in[I_PSW] + (size_t)l * 512 * DM, 512, DM, c.Pbr() + (size_t)3 * DM * 512, lds);
    cvt_mat(c.in[I_WO] + (size_t)l * DM * DM, DM, DM, c.Wo(), lds);
    cvt_mat(c.in[I_WUP] + (size_t)l * DM * DFF, DM, DFF, c.Wup(), lds);
    cvt_mat(c.in[I_WDN] + (size_t)l * DFF * DM, DFF, DM, c.Wdn(), lds);
}

DEVINL void phase_norm(const Ctx& c, const float* __restrict__ g, bool mask_pads) {
    const int lane = TID & 63, wid = (BID * NTHR + TID) >> 6, nw = gridDim.x * (NTHR / 64);
    f32x4 gv[4];
#pragma unroll
    for (int i = 0; i < 4; ++i) gv[i] = *(const f32x4*)(g + i * 256 + lane * 4);
    for (int t = wid; t < T; t += nw) {
        const int p = t % L;
        bf16_t* hp = c.H() + (size_t)t * DM;
        if (mask_pads && p < 112) {
            u32x2 z = {0u, 0u};
#pragma unroll
            for (int i = 0; i < 4; ++i) *(u32x2*)(hp + i * 256 + lane * 4) = z;
            continue;
        }
        const float* xp = xrow(c, t);
        f32x4 v[4]; float ss = 0.f;
#pragma unroll
        for (int i = 0; i < 4; ++i) { v[i] = *(const f32x4*)(xp + i * 256 + lane * 4); ss += v[i][0] * v[i][0] + v[i][1] * v[i][1] + v[i][2] * v[i][2] + v[i][3] * v[i][3]; }
        ss = wave_sum(ss);
        const float rs = rsqrtf(ss * (1.f / DM) + 1e-6f);
#pragma unroll
        for (int i = 0; i < 4; ++i) {
            u32x2 o; o[0] = cvt_pk_bf16(v[i][0] * rs * gv[i][0], v[i][1] * rs * gv[i][1]); o[1] = cvt_pk_bf16(v[i][2] * rs * gv[i][2], v[i][3] * rs * gv[i][3]);
            *(u32x2*)(hp + i * 256 + lane * 4) = o;
        }
    }
}

#define LAS __attribute__((address_space(3)))
constexpr int LROW = 144;
constexpr int A_ST = 256 * 128, B_ST = 128 * 128, STAGE = A_ST + B_ST;
template <int NI>
DEVINL void gemm_kloop(const bf16_t* __restrict__ A, int lda, const bf16_t* __restrict__ Bt, int ldb, int K, int m0, int n0,
                       unsigned char* lds, f32x16 (&acc)[NI][2]) {
    const int tid = TID, lane = tid & 63, w = tid >> 6, wm = w & 3, wn = w >> 2, r = lane & 31, h = lane >> 5;
    const int lrow = tid >> 3, cg = (tid & 7) ^ ((tid >> 4) & 7);
    const bf16_t* ga = A + (size_t)(m0 + lrow) * lda + cg * 8;
    const bf16_t* gb = Bt + (size_t)(n0 + lrow) * ldb + cg * 8;
    unsigned char* da = lds + tid * 16;
    unsigned char* db = lds + A_ST + tid * 16;
#define GEMM_ISSUE(stg, kt) do { const int k0_ = (kt) * 64; \
        _Pragma("unroll") for (int i = 0; i < 4; ++i) __builtin_amdgcn_global_load_lds((const void*)(ga + (size_t)(i * 64) * lda + k0_), (LAS void*)(da + (stg) * STAGE + i * 8192), 16, 0, 0); \
        _Pragma("unroll") for (int i = 0; i < NI; ++i) __builtin_amdgcn_global_load_lds((const void*)(gb + (size_t)(i * 64) * ldb + k0_), (LAS void*)(db + (stg) * STAGE + i * 8192), 16, 0, 0); } while (0)
    const int nt = K >> 6;
    asm volatile("s_waitcnt lgkmcnt(0)" ::: "memory");
    __builtin_amdgcn_s_barrier();
    GEMM_ISSUE(0, 0);
    if (nt > 1) GEMM_ISSUE(1, 1);
    const int sw = (r >> 1) & 7;
    int o4[4];
#pragma unroll
    for (int ks = 0; ks < 4; ++ks) o4[ks] = ((ks * 2 + h) ^ sw) * 16;
    int cur = 0;
    for (int t = 0; t < nt; ++t) {
        if (t + 1 < nt) { if (NI == 2) asm volatile("s_waitcnt vmcnt(6)" ::: "memory"); else asm volatile("s_waitcnt vmcnt(5)" ::: "memory"); }
        else asm volatile("s_waitcnt vmcnt(0)" ::: "memory");
        __builtin_amdgcn_s_barrier();
        if (t + 2 < nt) { const int s2 = (cur >= 1) ? cur - 1 : 2; GEMM_ISSUE(s2, t + 2); }
        const unsigned char* pa = lds + cur * STAGE + (wm * 64 + r) * 128;
        const unsigned char* pb = lds + cur * STAGE + A_ST + (wn * 32 * NI + r) * 128;
        bf16x8 af[2][2], bfr[2][NI];
#pragma unroll
        for (int i = 0; i < 2; ++i) af[0][i] = *(const bf16x8*)(pa + i * 32 * 128 + o4[0]);
#pragma unroll
        for (int i = 0; i < NI; ++i) bfr[0][i] = *(const bf16x8*)(pb + i * 32 * 128 + o4[0]);
#pragma unroll
        for (int ks = 0; ks < 4; ++ks) {
            if (ks < 3) {
#pragma unroll
                for (int i = 0; i < 2; ++i) af[(ks + 1) & 1][i] = *(const bf16x8*)(pa + i * 32 * 128 + o4[ks + 1]);
#pragma unroll
                for (int i = 0; i < NI; ++i) bfr[(ks + 1) & 1][i] = *(const bf16x8*)(pb + i * 32 * 128 + o4[ks + 1]);
            }
#pragma unroll
            for (int ni = 0; ni < NI; ++ni)
#pragma unroll
                for (int mi = 0; mi < 2; ++mi) acc[ni][mi] = MFMA32(bfr[ks & 1][ni], af[ks & 1][mi], acc[ni][mi]);
        }
        cur = (cur == 2) ? 0 : cur + 1;
    }
#undef GEMM_ISSUE
}
template <int NA>
DEVINL void zero_acc(f32x16 (&acc)[NA][2]) {
#pragma unroll
    for (int a = 0; a < NA; ++a)
#pragma unroll
        for (int b = 0; b < 2; ++b)
#pragma unroll
            for (int i = 0; i < 16; ++i) acc[a][b][i] = 0.f;
}


DEVINL void store_rows_via_lds(unsigned char* lds, const u32x2 (&pk)[2][2][4], bf16_t* out_row0, int ld) {
    const int tid = TID, lane = tid & 63, w = tid >> 6, r = lane & 31, h = lane >> 5;
    unsigned char* reg = lds + w * (64 * 144);
    __syncthreads();
#pragma unroll
    for (int mi = 0; mi < 2; ++mi)
#pragma unroll
        for (int ni = 0; ni < 2; ++ni)
#pragma unroll
            for (int g = 0; g < 4; ++g) *(u32x2*)(reg + (mi * 32 + r) * 144 + (ni * 32 + 8 * g + 4 * h) * 2) = pk[mi][ni][g];
    __syncthreads();
#pragma unroll
    for (int it = 0; it < 8; ++it) {
        const int idx = it * 64 + lane, row = idx >> 3, c16 = idx & 7;
        const u32x4 v = *(const u32x4*)(reg + row * 144 + c16 * 16);
        *(u32x4*)(out_row0 + (size_t)row * ld + c16 * 8) = v;
    }
}


DEVINL void store_cols_via_lds(unsigned char* lds, const u32x2 (&pk)[2][2][4], bf16_t* vt_col0  ) {
    const int tid = TID, lane = tid & 63, w = tid >> 6, r = lane & 31, h = lane >> 5;
    unsigned char* reg = lds + w * (64 * 144);
    __syncthreads();
#pragma unroll
    for (int mi = 0; mi < 2; ++mi)
#pragma unroll
        for (int ni = 0; ni < 2; ++ni)
#pragma unroll
            for (int g = 0; g < 4; ++g) {
                const int n = ni * 32 + 8 * g + 4 * h, m = mi * 32 + r;
                *(bf16_t*)(reg + (n + 0) * 144 + m * 2) = (bf16_t)(pk[mi][ni][g][0] & 0xffffu);
                *(bf16_t*)(reg + (n + 1) * 144 + m * 2) = (bf16_t)(pk[mi][ni][g][0] >> 16);
                *(bf16_t*)(reg + (n + 2) * 144 + m * 2) = (bf16_t)(pk[mi][ni][g][1] & 0xffffu);
                *(bf16_t*)(reg + (n + 3) * 144 + m * 2) = (bf16_t)(pk[mi][ni][g][1] >> 16);
            }
    __syncthreads();
#pragma unroll
    for (int it = 0; it < 8; ++it) {
        const int idx = it * 64 + lane, n = idx >> 3, c16 = idx & 7;
        const u32x4 v = *(const u32x4*)(reg + n * 144 + c16 * 16);
        *(u32x4*)(vt_col0 + (size_t)n * L + c16 * 8) = v;
    }
}

DEVINL void epi_inproj(const Ctx& c, int layer, f32x16 (&acc)[2][2], int mbase, int nbase, unsigned char* lds) {
    const int lane = TID & 63, r = lane & 31, h = lane >> 5;
    const int n = nbase;
    int zc = -1, tr = 0, vcol = 0, vC = 0; bf16_t* vt = nullptr; float scale = 1.f; const float* gain = nullptr;
    if (n < 512) { zc = Z_AQ + n; scale = QS; }
    else if (n < 1024) { zc = Z_AK + (n - 512); }
    else if (n < 1536) { vt = c.AVT(); vcol = n - 1024; vC = 512; }
    else if (n < 1792) { zc = Z_BQ + (n - 1536); }
    else if (n < 2048) { zc = Z_BK + (n - 1792); scale = 0.125f; vt = c.BKT(); vcol = n - 1792; vC = 256; }
    else if (n < 2560) { vt = c.BVT(); vcol = n - 2048; vC = 512; }
    else if (n < 3072) { zc = Z_BG + (n - 2560); }
    else if (n < 4864) { zc = Z_C + (n - 3072); }
    else if (n < 5376) { zc = Z_DQ + (n - 4864); tr = 1; scale = QS; gain = c.in[I_QNG] + layer * 64; }
    else if (n < 5504) { zc = Z_DK + (n - 5376); tr = 1; gain = c.in[I_KNG] + layer * 64; }
    else if (n < 5632) { vt = c.DVT(); vcol = n - 5504; vC = 128; }
    else if (n < 9728) { zc = Z_GZ + (n - 5632); tr = 2; }
    else { zc = Z_VL + (n - 9728); }
    u32x2 pkz[2][2][4];
#pragma unroll
    for (int mi = 0; mi < 2; ++mi) {
        const int m = mbase + mi * 32 + r;
        const int b = m / L, p = m - b * L;
        float rs = scale;
        if (tr == 1) {
            float ss = 0.f;
#pragma unroll
            for (int ni = 0; ni < 2; ++ni)
#pragma unroll
                for (int i = 0; i < 16; ++i) ss += acc[ni][mi][i] * acc[ni][mi][i];
            ss += __shfl_xor(ss, 32);
            rs = rsqrtf(ss * (1.f / 64.f) + 1e-6f) * scale;
        }
#pragma unroll
        for (int ni = 0; ni < 2; ++ni)
#pragma unroll
            for (int g = 0; g < 4; ++g) {
                const int nl = ni * 32 + 8 * g + 4 * h;
                float v[4];
#pragma unroll
                for (int j = 0; j < 4; ++j) v[j] = acc[ni][mi][4 * g + j];
                if (tr == 1) {
                    const f32x4 gg = *(const f32x4*)(gain + nl);
#pragma unroll
                    for (int j = 0; j < 4; ++j) v[j] *= rs * gg[j];
                } else if (tr == 2) {
#pragma unroll
                    for (int j = 0; j < 4; ++j) v[j] = sigmoidf_(v[j]);
                } else {
#pragma unroll
                    for (int j = 0; j < 4; ++j) v[j] *= scale;
                }
                { u32x2 o; o[0] = cvt_pk_bf16(v[0], v[1]); o[1] = cvt_pk_bf16(v[2], v[3]); pkz[mi][ni][g] = o; }
            }
    }
    if (zc >= 0) store_rows_via_lds(lds, pkz, c.Z() + (size_t)mbase * ZW + zc, ZW);
    if (vt) { const int b0 = mbase / L, p0 = mbase - b0 * L; store_cols_via_lds(lds, pkz, vt + ((size_t)(b0 * vC + vcol)) * L + p0); }
}
DEVINL void phase_inproj(const Ctx& c, int layer, unsigned char* lds, bool trivial = false) {
    const int MT = T / 256, NT = NZP / 128, total = MT * NT;
    const int w = TID >> 6, wm = w & 3, wn = w >> 2;
    for (int q = slot_of_block(); q < total; q += gridDim.x) {
        int tm, tn; tile_of(q, MT, NT, tm, tn);
        f32x16 acc[2][2]; zero_acc(acc);
        gemm_kloop<2>(c.H(), DM, c.Win(), DM, DM, tm * 256, tn * 128, lds, acc);
        if (trivial) {
            const int lane = TID & 63, r = lane & 31, h = lane >> 5;
            u32x2 pk[2][2][4];
#pragma unroll
            for (int mi = 0; mi < 2; ++mi)
#pragma unroll
                for (int ni = 0; ni < 2; ++ni)
#pragma unroll
                    for (int g = 0; g < 4; ++g) { pk[mi][ni][g][0] = cvt_pk_bf16(acc[ni][mi][4 * g], acc[ni][mi][4 * g + 1]); pk[mi][ni][g][1] = cvt_pk_bf16(acc[ni][mi][4 * g + 2], acc[ni][mi][4 * g + 3]); }
            const int zc = (tn < 68 ? tn : tn - 9) * 128 + wn * 64;
            store_rows_via_lds(lds, pk, c.Z() + (size_t)(tm * 256 + wm * 64) * ZW + zc, ZW);
        } else
        epi_inproj(c, layer, acc, tm * 256 + wm * 64, tn * 128 + wn * 64, lds);
    }
}

DEVINL void phase_rwproj(const Ctx& c, int layer, float* act) {
    const int tid = TID, col = tid;
    const float* mu = c.in[I_MU] + layer * 1792;
    const float mu_r = mu[col], mu_k = mu[512 + col], mu_v = mu[1024 + col];
    const float w0c = c.in[I_W0][layer * 512 + col], a0c = c.in[I_A0][layer * 512 + col];
    const float kkc = c.in[I_KKW][layer * 512 + col], kac = c.in[I_KAW][layer * 512 + col];
    const float v0c = layer > 0 ? c.in[I_V0][(layer - 1) * 512 + col] : 0.f;
    const float* w2 = c.in[I_W2] + (size_t)layer * 64 * 512 + col;
    const float* a2 = c.in[I_A2] + (size_t)layer * 64 * 512 + col;
    const float* g2 = c.in[I_G2] + (size_t)layer * 128 * 512 + col;
    const float* v2 = c.in[I_V2] + (size_t)(layer > 0 ? layer - 1 : 0) * 32 * 512 + col;
    bf16_t* R = c.RW(); bf16_t* LD = c.RW() + (size_t)T * 512; bf16_t* KP = c.RW() + (size_t)2 * T * 512; bf16_t* VP = c.RW() + (size_t)3 * T * 512;
    bf16_t* KK = c.RW() + (size_t)4 * T * 512; bf16_t* BB = c.RW() + (size_t)5 * T * 512; bf16_t* GG = c.RW() + (size_t)6 * T * 512;
    for (int task = BID; task < T / 8; task += gridDim.x) {
        const int t0 = task * 8;
        __syncthreads();
        for (int e = tid; e < 288 * 8; e += NTHR) {
            const int tok = e / 288, k = e - tok * 288;
            const int t = t0 + tok, p = t % L;
            float v;
            if (k < 256) {
                const int zcol = Z_C + 1536 + k;
                const float cur = bf2f(c.Z()[(size_t)t * ZW + zcol]);
                const float prev = p > 0 ? bf2f(c.Z()[(size_t)(t - 1) * ZW + zcol]) : 0.f;
                v = cur + (prev - cur) * mu[1536 + k];
                if (k < 64) v = tanhf(v); else if (k >= 128) v = sigmoidf_(v);
            } else v = bf2f(c.Z()[(size_t)t * ZW + Z_VL + (k - 256)]);
            act[k * 8 + tok] = v;
        }
        __syncthreads();
        float aw[8], aa[8], ag[8], av[8];
#pragma unroll
        for (int i = 0; i < 8; ++i) { aw[i] = 0.f; aa[i] = 0.f; ag[i] = 0.f; av[i] = 0.f; }
        for (int k = 0; k < 64; ++k) {
            const float wv = w2[(size_t)k * 512], avv = a2[(size_t)k * 512];
#pragma unroll
            for (int q4 = 0; q4 < 2; ++q4) {
                const f32x4 x = *(const f32x4*)(act + k * 8 + q4 * 4), y = *(const f32x4*)(act + (64 + k) * 8 + q4 * 4);
#pragma unroll
                for (int j = 0; j < 4; ++j) { aw[q4 * 4 + j] += wv * x[j]; aa[q4 * 4 + j] += avv * y[j]; }
            }
        }
        for (int k = 0; k < 128; ++k) {
            const float gv = g2[(size_t)k * 512];
#pragma unroll
            for (int q4 = 0; q4 < 2; ++q4) {
                const f32x4 x = *(const f32x4*)(act + (128 + k) * 8 + q4 * 4);
#pragma unroll
                for (int j = 0; j < 4; ++j) ag[q4 * 4 + j] += gv * x[j];
            }
        }
        if (layer > 0) {
            for (int k = 0; k < 32; ++k) {
                const float vv = v2[(size_t)k * 512];
#pragma unroll
                for (int q4 = 0; q4 < 2; ++q4) {
                    const f32x4 x = *(const f32x4*)(act + (256 + k) * 8 + q4 * 4);
#pragma unroll
                    for (int j = 0; j < 4; ++j) av[q4 * 4 + j] += vv * x[j];
                }
            }
        }
#pragma unroll
        for (int tok = 0; tok < 8; ++tok) {
            const int t = t0 + tok, p = t % L;
            const bf16_t* zr = c.Z() + (size_t)t * ZW + Z_C + col;
            float rc = bf2f(zr[0]), kc = bf2f(zr[512]), vc = bf2f(zr[1024]);
            float rp = 0.f, kp = 0.f, vp = 0.f;
            if (p > 0) { rp = bf2f(zr[-ZW]); kp = bf2f(zr[512 - ZW]); vp = bf2f(zr[1024 - ZW]); }
            rc += (rp - rc) * mu_r; kc += (kp - kc) * mu_k; vc += (vp - vc) * mu_v;
            const float u = -(w0c + aw[tok]);
            const float spl = fmaxf(u, 0.f) + __logf(1.f + __expf(-fabsf(u)));
            const float wlog = -spl - 0.5f;
            const float ld = -__expf(wlog);
            const float a = sigmoidf_(a0c + aa[tok]);
            const float kkraw = kc * kkc;
            const float ss = wave_sum(kkraw * kkraw);
            const float kk = kkraw / fmaxf(sqrtf(ss), 1e-12f);
            const float kmod = kc * (1.f + (a - 1.f) * kac);
            const size_t o = (size_t)t * 512 + col;
            float vout = vc;
            if (layer == 0) c.VF()[o] = f2bf(vc);
            else { const float vf = bf2f(c.VF()[o]); vout = vc + (vf - vc) * sigmoidf_(v0c + av[tok]); }
            asm volatile("" ::: "memory");
            R[o] = f2bf(rc); LD[o] = f2bf(ld * LOG2E); KP[o] = f2bf(kmod); VP[o] = f2bf(vout); KK[o] = f2bf(kk); BB[o] = f2bf(kk * a); GG[o] = f2bf(ag[tok]);
        }
    }
}

constexpr int TC = 16, NCH = L / TC, STG = 7 * TC * 64;
struct RwOps { f32x4 w[2], k[2], kk[2], b[2], r[2]; f32x2 v; };
DEVINL void rw_load_ops(RwOps& o, const float* buf, int tt, int jo, int i0) {
    const float* p = buf + tt * 64 + jo * 8;
#pragma unroll
    for (int q = 0; q < 2; ++q) {
        o.r[q] = *(const f32x4*)(p + q * 4); o.w[q] = *(const f32x4*)(p + TC * 64 + q * 4); o.k[q] = *(const f32x4*)(p + 2 * TC * 64 + q * 4);
        o.kk[q] = *(const f32x4*)(p + 4 * TC * 64 + q * 4); o.b[q] = *(const f32x4*)(p + 5 * TC * 64 + q * 4);
    }
    o.v = *(const f32x2*)(buf + 3 * TC * 64 + tt * 64 + i0);
}
DEVINL float oct_sum(float v) { v += DPPF(v, 0xB1); v += DPPF(v, 0x4E); v += DPPF(v, 0x141); return v; }
DEVINL f32x2 rw_step(f32x2 (&S0)[4], f32x2 (&S1)[4], const RwOps& o) {
    f32x2 a0 = {0.f, 0.f}, a1 = {0.f, 0.f};
#pragma unroll
    for (int p = 0; p < 4; ++p) { const f32x2 kk2 = {o.kk[p >> 1][(p & 1) * 2], o.kk[p >> 1][(p & 1) * 2 + 1]}; a0 += S0[p] * kk2; a1 += S1[p] * kk2; }
    const float sa0 = oct_sum(a0[0] + a0[1]), sa1 = oct_sum(a1[0] + a1[1]);
    const f32x2 n0 = {-sa0, -sa0}, n1 = {-sa1, -sa1}, v0 = {o.v[0], o.v[0]}, v1 = {o.v[1], o.v[1]};
    f32x2 y0 = {0.f, 0.f}, y1 = {0.f, 0.f};
#pragma unroll
    for (int p = 0; p < 4; ++p) {
        const int q = p >> 1, e = (p & 1) * 2;
        const f32x2 k2 = {o.k[q][e], o.k[q][e + 1]}, b2 = {o.b[q][e], o.b[q][e + 1]}, w2 = {o.w[q][e], o.w[q][e + 1]}, r2 = {o.r[q][e], o.r[q][e + 1]};
        S0[p] = S0[p] * w2 + (v0 * k2 + n0 * b2);
        S1[p] = S1[p] * w2 + (v1 * k2 + n1 * b2);
        y0 += S0[p] * r2; y1 += S1[p] * r2;
    }
    f32x2 y = {oct_sum(y0[0] + y0[1]), oct_sum(y1[0] + y1[1])};
    return y;
}
DEVINL void rw_stage(const bf16_t* rwbase, int t0, int hd, float* buf, int ht, int nth) {
    for (int item = ht; item < 7 * TC * 8; item += nth) {
        const int arr = item / (TC * 8), rem = item - arr * (TC * 8), tt = rem >> 3, c8 = rem & 7;
        const u32x4 raw = *(const u32x4*)(rwbase + (size_t)arr * T * 512 + (size_t)(t0 + tt) * 512 + hd * 64 + c8 * 8);
        f32x4 lo = {bflo(raw[0]), bfhi(raw[0]), bflo(raw[1]), bfhi(raw[1])}, hi = {bflo(raw[2]), bfhi(raw[2]), bflo(raw[3]), bfhi(raw[3])};
        if (arr == 1) {
#pragma unroll
            for (int j = 0; j < 4; ++j) { lo[j] = fexp2(lo[j]); hi[j] = fexp2(hi[j]); }
        }
        float* d = buf + arr * TC * 64 + tt * 64 + c8 * 8;
        *(f32x4*)d = lo; *(f32x4*)(d + 4) = hi;
    }
}
DEVINL void rw_stage_load(u32x4 (&raw)[4], const bf16_t* rwbase, int t0, int hd, int ht) {
    const int rem = ht & 127, tt = rem >> 3, c8 = rem & 7;
#pragma unroll
    for (int k = 0; k < 4; ++k) {
        const int arr = (ht >> 7) + 2 * k;
        if (arr < 7) raw[k] = *(const u32x4*)(rwbase + (size_t)arr * T * 512 + (size_t)(t0 + tt) * 512 + hd * 64 + c8 * 8);
    }
}
DEVINL void rw_stage_write(const u32x4 (&raw)[4], float* buf, int ht) {
    const int rem = ht & 127, tt = rem >> 3, c8 = rem & 7;
#pragma unroll
    for (int k = 0; k < 4; ++k) {
        const int arr = (ht >> 7) + 2 * k;
        if (arr < 7) {
            f32x4 lo = {bflo(raw[k][0]), bfhi(raw[k][0]), bflo(raw[k][1]), bfhi(raw[k][1])}, hi = {bflo(raw[k][2]), bfhi(raw[k][2]), bflo(raw[k][3]), bfhi(raw[k][3])};
            if (arr == 1) {
#pragma unroll
                for (int j = 0; j < 4; ++j) { lo[j] = fexp2(lo[j]); hi[j] = fexp2(hi[j]); }
            }
            float* d = buf + arr * TC * 64 + tt * 64 + c8 * 8;
            *(f32x4*)d = lo; *(f32x4*)(d + 4) = hi;
        }
    }
}
DEVINL void rw_wait_ready(const unsigned* cnt3, unsigned need, int nP) {
    for (int j = 0; j < nP; ++j)
        while (__hip_atomic_load(cnt3 + j, __ATOMIC_RELAXED, __HIP_MEMORY_SCOPE_AGENT) < need) __builtin_amdgcn_s_sleep(8);
    __builtin_amdgcn_fence(__ATOMIC_ACQUIRE, "agent");
    asm volatile("s_waitcnt vmcnt(0)" ::: "memory");
}
DEVINL void rwkv_scan(const Ctx& c, int layer, int b, int hd, const unsigned* cnt3, int nP, float* lds) {
    float* sy = lds + 3 * STG;
    const int tid = TID, lane = tid & 63, w = tid >> 6;
    const bf16_t* rwbase = c.RW();
    const bf16_t* GG = c.RW() + (size_t)6 * T * 512;
    bf16_t* Y = c.Y() + (size_t)2 * T * 512;
    const int rp = lane >> 3, jo = lane & 7, i0 = 16 * (w & 3) + 2 * rp;
    f32x2 S0[4], S1[4];
#pragma unroll
    for (int j = 0; j < 4; ++j) { S0[j] = (f32x2){0.f, 0.f}; S1[j] = (f32x2){0.f, 0.f}; }
    const float lng = c.in[I_LNG][layer * 512 + hd * 64 + lane], lnb = c.in[I_LNB][layer * 512 + hd * 64 + lane], rkv = c.in[I_RK][layer * 512 + hd * 64 + lane];
    __syncthreads();
    unsigned have = (unsigned)(layer * 16 + 1);
    rw_wait_ready(cnt3, have, nP);
    rw_stage(rwbase, b * L, hd, lds, tid, NTHR);
    u32x4 raw[4];
#pragma unroll
    for (int k = 0; k < 4; ++k) raw[k] = (u32x4){0u, 0u, 0u, 0u};
    if (w >= 4) rw_stage_load(raw, rwbase, b * L + TC, hd, tid - 256);
    __syncthreads();
    for (int ch = 0; ch <= NCH; ++ch) {
        if (w < 4) {
            if (ch < NCH) {
                const float* buf = lds + (ch % 3) * STG;
                float* syw = sy + (ch & 1) * TC * 64;
                RwOps ops[3];
                rw_load_ops(ops[0], buf, 0, jo, i0);
                rw_load_ops(ops[1], buf, 1, jo, i0);
#pragma unroll
                for (int tt = 0; tt < TC; ++tt) {
                    if (tt + 2 < TC) rw_load_ops(ops[(tt + 2) % 3], buf, tt + 2, jo, i0);
                    const f32x2 y = rw_step(S0, S1, ops[tt % 3]);
                    *(f32x2*)(syw + tt * 64 + i0) = y;
                }
            }
        } else {
            const int ht = tid - 256, hw = w - 4;
            if (ch + 1 < NCH) rw_stage_write(raw, lds + ((ch + 1) % 3) * STG, ht);
            if (ch + 2 < NCH) {
                const unsigned need = (unsigned)(layer * 16 + (ch + 2) / (7 * nP) + 1);
                if (need > have) { rw_wait_ready(cnt3, need, nP); have = need; }
                rw_stage_load(raw, rwbase, b * L + (ch + 2) * TC, hd, ht);
            }
            if (ch >= 1) {
                const int pc = ch - 1, t0 = b * L + pc * TC;
                const float* buf = lds + (pc % 3) * STG;
                const float* syr = sy + (pc & 1) * TC * 64;
#pragma unroll
                for (int k4 = 0; k4 < TC / 4; ++k4) {
                    const int tt = hw + 4 * k4, e = tt * 64 + lane;
                    const float y = syr[e];
                    const size_t idx = (size_t)(t0 + tt) * 512 + hd * 64 + lane;
                    const float gate = buf[6 * TC * 64 + e];
                    const float s1 = wave_sum_dpp(y), s2 = wave_sum_dpp(y * y), s3 = wave_sum_dpp(buf[e] * buf[2 * TC * 64 + e] * rkv);
                    const float mean = s1 * (1.f / 64.f);
                    const float var = fmaxf(s2 * (1.f / 64.f) - mean * mean, 0.f);
                    const float yn = (y - mean) * rsqrtf(var + 64e-5f) * lng + lnb;
                    Y[idx] = f2bf((yn + s3 * buf[3 * TC * 64 + e]) * gate);
                }
            }
        }
        __syncthreads();
    }
}


typedef float f32x4v __attribute__((ext_vector_type(4)));
#define MFMA16(a, b, c) __builtin_amdgcn_mfma_f32_16x16x32_bf16((a), (b), (c), 0, 0, 0)
constexpr int RP_KP = 296, RP_BW_BYTES = 64 * RP_KP * 2, RP_WAVE_BYTES = 16 * RP_KP * 2 + 16 * 192 * 2, RP_NW = 7, RP_NG = L / 16;
DEVINL float row16_sum(float v) { v += DPPF(v, 0xB1); v += DPPF(v, 0x4E); v += DPPF(v, 0x141); v += DPPF(v, 0x140); return v; }
DEVINL void rw_project_head(const Ctx& c, int layer, int b, int hd, int pj, int nP, unsigned* cnt, unsigned char* lds) {
    const int tid = TID, lane = tid & 63, w = tid >> 6, cl = lane & 15, kg = lane >> 4;
    bf16_t* BW = (bf16_t*)lds;
    bf16_t* ACT = (bf16_t*)(lds + RP_BW_BYTES + (w < RP_NW ? w : 0) * RP_WAVE_BYTES);
    bf16_t* RKV = ACT + 16 * RP_KP;
    const float* mu = c.in[I_MU] + layer * 1792;
    __syncthreads();
    {
        const float* w2 = c.in[I_W2] + (size_t)layer * 64 * 512 + hd * 64;
        const float* a2 = c.in[I_A2] + (size_t)layer * 64 * 512 + hd * 64;
        const float* g2 = c.in[I_G2] + (size_t)layer * 128 * 512 + hd * 64;
        const float* v2 = c.in[I_V2] + (size_t)(layer > 0 ? layer - 1 : 0) * 32 * 512 + hd * 64;
        for (int e = tid; e < 64 * 288; e += NTHR) {
            const int k = e >> 6, col = e & 63;
            float v;
            if (k < 64) v = w2[(size_t)k * 512 + col];
            else if (k < 128) v = a2[(size_t)(k - 64) * 512 + col];
            else if (k < 256) v = g2[(size_t)(k - 128) * 512 + col];
            else v = layer > 0 ? v2[(size_t)(k - 256) * 512 + col] : 0.f;
            BW[col * RP_KP + k] = f2bf(v);
        }
    }
    float w0c[4], a0c[4], kkc[4], kac[4], v0c[4];
#pragma unroll
    for (int nt = 0; nt < 4; ++nt) {
        const int col = layer * 512 + hd * 64 + nt * 16 + cl;
        w0c[nt] = c.in[I_W0][col]; a0c[nt] = c.in[I_A0][col]; kkc[nt] = c.in[I_KKW][col]; kac[nt] = c.in[I_KAW][col];
        v0c[nt] = layer > 0 ? c.in[I_V0][(layer - 1) * 512 + hd * 64 + nt * 16 + cl] : 0.f;
    }
    bf16_t* R = c.RW(); bf16_t* LD = c.RW() + (size_t)T * 512; bf16_t* KP = c.RW() + (size_t)2 * T * 512; bf16_t* VP = c.RW() + (size_t)3 * T * 512;
    bf16_t* KK = c.RW() + (size_t)4 * T * 512; bf16_t* BB = c.RW() + (size_t)5 * T * 512; bf16_t* GG = c.RW() + (size_t)6 * T * 512;
    const bf16_t* Zb = c.Z();
    int round = 0;
    for (int q0 = 0; nP * q0 + pj < RP_NG; q0 += RP_NW, ++round) {
        const int g = nP * (q0 + w) + pj;
        const bool act = (w < RP_NW) && (g < RP_NG);
        const int t0 = b * L + g * 16;
        __syncthreads();
        if (act) {
            {
                const int ch = lane & 31, par = lane >> 5, k = ch * 8;
                const f32x4 m0 = *(const f32x4*)(mu + 1536 + k), m1 = *(const f32x4*)(mu + 1536 + k + 4);
                const float fa = (ch < 8) ? 1.f : 0.f, fb = (ch < 8) ? -2.f : 1.f, fs = (ch < 8) ? 2.f * LOG2E : -LOG2E;
                const bool ident = (ch >= 8 && ch < 16);
                u32x4 cu[8], pr[8];
#pragma unroll
                for (int i = 0; i < 8; ++i) {
                    const int t = t0 + 2 * i + par;
                    cu[i] = *(const u32x4*)(Zb + (size_t)t * ZW + Z_C + 1536 + k);
                    pr[i] = (u32x4){0u, 0u, 0u, 0u};
                    if (t - b * L > 0) pr[i] = *(const u32x4*)(Zb + (size_t)(t - 1) * ZW + Z_C + 1536 + k);
                }
#pragma unroll
                for (int i = 0; i < 8; ++i) {
                    u32x4 o;
#pragma unroll
                    for (int j = 0; j < 4; ++j) {
                        const float c0 = bflo(cu[i][j]), c1 = bfhi(cu[i][j]), p0 = bflo(pr[i][j]), p1 = bfhi(pr[i][j]);
                        const float ma = (j < 2) ? m0[2 * j] : m1[2 * j - 4], mb = (j < 2) ? m0[2 * j + 1] : m1[2 * j - 3];
                        const float x0 = c0 + (p0 - c0) * ma, x1 = c1 + (p1 - c1) * mb;
                        const float y0 = fa + fb * __builtin_amdgcn_rcpf(1.f + fexp2(x0 * fs)), y1 = fa + fb * __builtin_amdgcn_rcpf(1.f + fexp2(x1 * fs));
                        o[j] = cvt_pk_bf16(ident ? x0 : y0, ident ? x1 : y1);
                    }
                    *(u32x4*)(ACT + (2 * i + par) * RP_KP + k) = o;
                }
                const int tokv = lane >> 2, kv = (lane & 3) * 8;
                *(u32x4*)(ACT + tokv * RP_KP + 256 + kv) = *(const u32x4*)(Zb + (size_t)(t0 + tokv) * ZW + Z_VL + kv);
            }
            {
                u32x4 cu[6], pr[6];
#pragma unroll
                for (int i = 0; i < 6; ++i) {
                    const int it = lane + 64 * i, tok = it / 24, rem = it - tok * 24, arr = rem >> 3, c8 = (rem & 7) * 8;
                    const int t = t0 + tok;
                    const int zcol = Z_C + arr * 512 + hd * 64 + c8;
                    cu[i] = *(const u32x4*)(Zb + (size_t)t * ZW + zcol);
                    pr[i] = (u32x4){0u, 0u, 0u, 0u};
                    if (t - b * L > 0) pr[i] = *(const u32x4*)(Zb + (size_t)(t - 1) * ZW + zcol);
                }
#pragma unroll
                for (int i = 0; i < 6; ++i) {
                    const int it = lane + 64 * i, tok = it / 24, rem = it - tok * 24, arr = rem >> 3, c8 = (rem & 7) * 8;
                    const f32x4 m0 = *(const f32x4*)(mu + arr * 512 + hd * 64 + c8), m1 = *(const f32x4*)(mu + arr * 512 + hd * 64 + c8 + 4);
                    u32x4 o;
#pragma unroll
                    for (int j = 0; j < 4; ++j) {
                        const float c0 = bflo(cu[i][j]), c1 = bfhi(cu[i][j]), p0 = bflo(pr[i][j]), p1 = bfhi(pr[i][j]);
                        const float ma = (j < 2) ? m0[2 * j] : m1[2 * j - 4], mb = (j < 2) ? m0[2 * j + 1] : m1[2 * j - 3];
                        o[j] = cvt_pk_bf16(c0 + (p0 - c0) * ma, c1 + (p1 - c1) * mb);
                    }
                    *(u32x4*)(RKV + tok * 192 + arr * 64 + c8) = o;
                }
            }
        }
        __syncthreads();
        if (act) {
            bf16x8 af[9];
#pragma unroll
            for (int ks = 0; ks < 9; ++ks) af[ks] = *(const bf16x8*)(ACT + cl * RP_KP + ks * 32 + kg * 8);
            float kkraw[4][4], av[4][4], ldv[4][4], gv[4][4], kmod[4][4], vout[4][4], rcv[4][4];
            float ss[4] = {0.f, 0.f, 0.f, 0.f};
#pragma unroll
            for (int nt = 0; nt < 4; ++nt) {
                const bf16_t* bp = BW + (nt * 16 + cl) * RP_KP + kg * 8;
                f32x4v aw = {0.f, 0.f, 0.f, 0.f}, aa = aw, ag = aw, avv = aw;
                aw = MFMA16(af[0], *(const bf16x8*)(bp), aw); aw = MFMA16(af[1], *(const bf16x8*)(bp + 32), aw);
                aa = MFMA16(af[2], *(const bf16x8*)(bp + 64), aa); aa = MFMA16(af[3], *(const bf16x8*)(bp + 96), aa);
#pragma unroll
                for (int ks = 4; ks < 8; ++ks) ag = MFMA16(af[ks], *(const bf16x8*)(bp + ks * 32), ag);
                avv = MFMA16(af[8], *(const bf16x8*)(bp + 256), avv);
#pragma unroll
                for (int rg = 0; rg < 4; ++rg) {
                    const int tk = kg * 4 + rg;
                    const bf16_t* rk = RKV + tk * 192 + nt * 16 + cl;
                    const float rc = bf2f(rk[0]), kc = bf2f(rk[64]), vc = bf2f(rk[128]);
                    const float u = -(w0c[nt] + aw[rg]);
                    const float spl = fmaxf(u, 0.f) + flog2(1.f + fexp2(-fabsf(u) * LOG2E)) * (1.f / LOG2E);
                    ldv[nt][rg] = -fexp2((-spl - 0.5f) * LOG2E) * LOG2E;
                    const float a = sigmoidf_(a0c[nt] + aa[rg]);
                    av[nt][rg] = a; gv[nt][rg] = ag[rg]; rcv[nt][rg] = rc;
                    const float kr = kc * kkc[nt];
                    kkraw[nt][rg] = kr; ss[rg] += kr * kr;
                    kmod[nt][rg] = kc * (1.f + (a - 1.f) * kac[nt]);
                    const size_t o = (size_t)(t0 + tk) * 512 + hd * 64 + nt * 16 + cl;
                    float vo = vc;
                    if (layer == 0) c.VF()[o] = f2bf(vc);
                    else { const float vf = bf2f(c.VF()[o]); vo = vc + (vf - vc) * sigmoidf_(v0c[nt] + avv[rg]); }
                    vout[nt][rg] = vo;
                }
            }
            float inv[4];
#pragma unroll
            for (int rg = 0; rg < 4; ++rg) inv[rg] = fminf(__builtin_amdgcn_rsqf(row16_sum(ss[rg])), 1e12f);
#pragma unroll
            for (int nt = 0; nt < 4; ++nt)
#pragma unroll
                for (int rg = 0; rg < 4; ++rg) {
                    const size_t o = (size_t)(t0 + kg * 4 + rg) * 512 + hd * 64 + nt * 16 + cl;
                    const float kk = kkraw[nt][rg] * inv[rg];
                    R[o] = f2bf(rcv[nt][rg]); LD[o] = f2bf(ldv[nt][rg]); KP[o] = f2bf(kmod[nt][rg]); VP[o] = f2bf(vout[nt][rg]);
                    KK[o] = f2bf(kk); BB[o] = f2bf(kk * av[nt][rg]); GG[o] = f2bf(gv[nt][rg]);
                }
        }
        asm volatile("s_waitcnt vmcnt(0)" ::: "memory");
        __syncthreads();
        if (threadIdx.x == 0) {
            __builtin_amdgcn_fence(__ATOMIC_RELEASE, "agent");
            __hip_atomic_store(cnt, (unsigned)(layer * 16 + round + 1), __ATOMIC_RELAXED, __HIP_MEMORY_SCOPE_AGENT);
        }
    }
    __syncthreads();
}

DEVINL void ret_block(const Ctx& c, int b, int hd, unsigned char* lds) {
    bf16_t* ST = (bf16_t*)lds;
    float* ssq = (float*)(lds + 128 * LROW);
    const int tid = TID, lane = tid & 63, w = tid >> 6, r = lane & 31, h = lane >> 5;
    const int qs = w & 3, dh = w >> 2, dvt = w >> 1, dt = w & 1;
    const float lg2 = flog2(1.f - fexp2(-5.f - (float)hd));
    const float gam = fexp2(lg2), gam128 = fexp2(lg2 * 128.f);
    f32x16 sacc;
#pragma unroll
    for (int i = 0; i < 16; ++i) sacc[i] = 0.f;
    const bf16_t* vtb = c.BVT() + (size_t)(b * 512 + hd * 128) * L;
    const bf16_t* ktb = c.BKT() + (size_t)(b * 256 + hd * 64) * L;
    bf16_t* Y = c.Y() + (size_t)T * 512;
    for (int ch = 0; ch < L / 128; ++ch) {
        const int t0 = b * L + ch * 128, p0 = ch * 128;
        __syncthreads();
#pragma unroll
        for (int i = 0; i < 16; ++i) {
            const int dv = dvt * 32 + (i & 3) + 8 * (i >> 2) + 4 * h;
            ST[dv * 72 + dt * 32 + r] = f2bf(sacc[i]);
        }
        __syncthreads();
        const int ql = qs * 32 + r;
        bf16x8 qf[4];
        const bf16_t* qp = c.Z() + (size_t)(t0 + ql) * ZW + Z_BQ + hd * 64 + 8 * h;
#pragma unroll
        for (int s = 0; s < 4; ++s) qf[s] = *(const bf16x8*)(qp + 16 * s);
        f32x16 o[2];
#pragma unroll
        for (int d = 0; d < 2; ++d) {
#pragma unroll
            for (int i = 0; i < 16; ++i) o[d][i] = 0.f;
#pragma unroll
            for (int s = 0; s < 4; ++s) {
                const bf16x8 sf = *(const bf16x8*)(ST + (dh * 64 + d * 32 + r) * 72 + 16 * s + 8 * h);
                o[d] = MFMA32(sf, qf[s], o[d]);
            }
#pragma unroll
            for (int i = 0; i < 16; ++i) o[d][i] *= gam;
        }
        for (int kt = 0; kt <= qs; ++kt) {
            const bf16_t* kp = c.Z() + (size_t)(t0 + kt * 32 + r) * ZW + Z_BK + hd * 64 + 8 * h;
            f32x16 st;
#pragma unroll
            for (int i = 0; i < 16; ++i) st[i] = 0.f;
#pragma unroll
            for (int s = 0; s < 4; ++s) { const bf16x8 kf = *(const bf16x8*)(kp + 16 * s); st = MFMA32(kf, qf[s], st); }
            bf16x8 pf[2];
#pragma unroll
            for (int s = 0; s < 2; ++s) {
                u32x4 pk;
#pragma unroll
                for (int jj = 0; jj < 4; ++jj) {
                    float a2[2];
#pragma unroll
                    for (int e = 0; e < 2; ++e) {
                        const int i = 8 * s + 2 * jj + e;
                        const int kl = kt * 32 + (i & 3) + 8 * (i >> 2) + 4 * h;
                        a2[e] = (kl <= ql) ? st[i] * fexp2(-lg2 * (float)kl) : 0.f;
                    }
                    pk[jj] = cvt_pk_bf16(a2[0], a2[1]);
                }
                pf[s] = __builtin_bit_cast(bf16x8, pk);
            }
#pragma unroll
            for (int d = 0; d < 2; ++d) {
                const bf16_t* vp = vtb + (size_t)(dh * 64 + d * 32 + r) * L + p0 + kt * 32 + 4 * h;
#pragma unroll
                for (int s = 0; s < 2; ++s) {
                    const u32x2 lo = *(const u32x2*)(vp + 16 * s), hi = *(const u32x2*)(vp + 16 * s + 8);
                    u32x4 vv = {lo[0], lo[1], hi[0], hi[1]};
                    o[d] = MFMA32(__builtin_bit_cast(bf16x8, vv), pf[s], o[d]);
                }
            }
        }
        const float gq = fexp2(lg2 * (float)ql);
        float ss = 0.f;
#pragma unroll
        for (int d = 0; d < 2; ++d)
#pragma unroll
            for (int i = 0; i < 16; ++i) { o[d][i] *= gq; ss += o[d][i] * o[d][i]; }
        ss += __shfl_xor(ss, 32);
        if (h == 0) ssq[dh * 128 + ql] = ss;
        __syncthreads();
        const float rs = rsqrtf((ssq[ql] + ssq[128 + ql]) * (1.f / 128.f) + 1e-6f);
        {
            const bf16_t* gp = c.Z() + (size_t)(t0 + ql) * ZW + Z_BG + hd * 128 + dh * 64;
            bf16_t* yp = Y + (size_t)(t0 + ql) * 512 + hd * 128 + dh * 64;
#pragma unroll
            for (int d = 0; d < 2; ++d)
#pragma unroll
                for (int g = 0; g < 4; ++g) {
                    const int dl = d * 32 + 8 * g + 4 * h;
                    const u32x2 gg = *(const u32x2*)(gp + dl);
                    float gv[4] = {bflo(gg[0]), bfhi(gg[0]), bflo(gg[1]), bfhi(gg[1])};
                    float ov[4];
#pragma unroll
                    for (int j = 0; j < 4; ++j) { const float sg = gv[j] * sigmoidf_(gv[j]); ov[j] = sg * o[d][4 * g + j] * rs; }
                    u32x2 pk; pk[0] = cvt_pk_bf16(ov[0], ov[1]); pk[1] = cvt_pk_bf16(ov[2], ov[3]);
                    *(u32x2*)(yp + dl) = pk;
                }
        }
#pragma unroll
        for (int i = 0; i < 16; ++i) sacc[i] *= gam128;
        {
            const bf16_t* va = vtb + (size_t)(dvt * 32 + r) * L + p0 + 8 * h;
            const bf16_t* kb = ktb + (size_t)(dt * 32 + r) * L + p0 + 8 * h;
#pragma unroll 2
            for (int ks = 0; ks < 8; ++ks) {
                const bf16x8 vf = *(const bf16x8*)(va + 16 * ks);
                const u32x4 kr = *(const u32x4*)(kb + 16 * ks);
                u32x4 kd;
#pragma unroll
                for (int jj = 0; jj < 4; ++jj) {
                    const int j0 = 16 * ks + 8 * h + 2 * jj;
                    kd[jj] = cvt_pk_bf16(bflo(kr[jj]) * fexp2(lg2 * (float)(127 - j0)), bfhi(kr[jj]) * fexp2(lg2 * (float)(126 - j0)));
                }
                sacc = MFMA32(vf, __builtin_bit_cast(bf16x8, kd), sacc);
            }
        }
    }
}

DEVINL void sb_task(const Ctx& c, int b, int hd, int qg) {
    const int lane = TID & 63, r = lane & 31, h = lane >> 5;
    const int q0 = qg * 32;
    bf16_t* yp = c.Y() + (size_t)(b * L + q0 + r) * 512 + hd * 64;
    if (qg < 3) {
        u32x2 z = {0u, 0u};
#pragma unroll
        for (int d = 0; d < 2; ++d)
#pragma unroll
            for (int g = 0; g < 4; ++g) *(u32x2*)(yp + d * 32 + 8 * g + 4 * h) = z;
        return;
    }
    const bf16_t* zb = c.Z() + (size_t)b * L * ZW;
    bf16x8 qf[4];
    {
        const bf16_t* qp = zb + (size_t)(q0 + r) * ZW + Z_AQ + hd * 64 + 8 * h;
#pragma unroll
        for (int s = 0; s < 4; ++s) qf[s] = *(const bf16x8*)(qp + 16 * s);
    }
    f32x16 o[2];
#pragma unroll
    for (int d = 0; d < 2; ++d)
#pragma unroll
        for (int i = 0; i < 16; ++i) o[d][i] = 0.f;
    float carry = 0.f;
    const int qpos = q0 + r;
    const bf16_t* vtb = c.AVT() + (size_t)(b * 512 + hd * 64 + r) * L + 4 * h;
    bf16x8 kfn[4], vfn[2][2], kfm[4], vfm[2][2];
#define SB_LOAD(KF, VF, KT) do { const int k0_ = (KT) * 32; const bf16_t* kp_ = zb + (size_t)(k0_ + r) * ZW + Z_AK + hd * 64 + 8 * h; \
        _Pragma("unroll") for (int s_ = 0; s_ < 4; ++s_) KF[s_] = *(const bf16x8*)(kp_ + 16 * s_); \
        _Pragma("unroll") for (int d_ = 0; d_ < 2; ++d_) _Pragma("unroll") for (int s_ = 0; s_ < 2; ++s_) { \
            const bf16_t* vp_ = vtb + (size_t)(d_ * 32) * L + k0_ + 16 * s_; const u32x2 lo_ = *(const u32x2*)(vp_), hi_ = *(const u32x2*)(vp_ + 8); \
            u32x4 vv_ = {lo_[0], lo_[1], hi_[0], hi_[1]}; VF[d_][s_] = __builtin_bit_cast(bf16x8, vv_); } } while (0)
    SB_LOAD(kfn, vfn, qg);
    SB_LOAD(kfm, vfm, (qg > 3 ? qg - 1 : 3));
    for (int kt = qg; kt >= 3; --kt) {
        const int k0 = kt * 32;
        bf16x8 kf[4], vf[2][2];
#pragma unroll
        for (int s = 0; s < 4; ++s) { kf[s] = kfn[s]; kfn[s] = kfm[s]; }
#pragma unroll
        for (int d = 0; d < 2; ++d)
#pragma unroll
            for (int s = 0; s < 2; ++s) { vf[d][s] = vfn[d][s]; vfn[d][s] = vfm[d][s]; }
        SB_LOAD(kfm, vfm, (kt > 4 ? kt - 2 : 3));
        f32x16 st;
#pragma unroll
        for (int i = 0; i < 16; ++i) st[i] = 0.f;
#pragma unroll
        for (int s = 0; s < 4; ++s) st = MFMA32(kf[s], qf[s], st);
        const bool boundary = (kt == qg) || (kt == 3);
        float x[16], ls[16];
#pragma unroll
        for (int i = 0; i < 16; ++i) {
            const float z = st[i];
            const float sp = fmaxf(z, 0.f) + flog2(1.f + fexp2(-fabsf(z)));
            const int key = k0 + (i & 3) + 8 * (i >> 2) + 4 * h;
            const bool ok = !boundary || (key < qpos && key >= 112);
            x[i] = ok ? -sp : 0.f;
            ls[i] = ok ? z - sp : -INFINITY;
        }
        float og[4], tot[4];
#pragma unroll
        for (int g = 0; g < 4; ++g) {
            const float gs = (x[4 * g] + x[4 * g + 1]) + (x[4 * g + 2] + x[4 * g + 3]);
            og[g] = __shfl_xor(gs, 32);
            tot[g] = gs + og[g];
        }
        float suf[4];
        suf[3] = 0.f; suf[2] = tot[3]; suf[1] = suf[2] + tot[2]; suf[0] = suf[1] + tot[1];
        float a[16];
#pragma unroll
        for (int g = 0; g < 4; ++g) {
            float af = carry + suf[g] + (h == 0 ? og[g] : 0.f);
            a[4 * g + 3] = fexp2(ls[4 * g + 3] + af); af += x[4 * g + 3];
            a[4 * g + 2] = fexp2(ls[4 * g + 2] + af); af += x[4 * g + 2];
            a[4 * g + 1] = fexp2(ls[4 * g + 1] + af); af += x[4 * g + 1];
            a[4 * g + 0] = fexp2(ls[4 * g + 0] + af);
        }
        carry += (tot[0] + tot[1]) + (tot[2] + tot[3]);
        const bool sb_done = __all(carry < -80.f);
#pragma unroll
        for (int s = 0; s < 2; ++s) {
            u32x4 pk;
#pragma unroll
            for (int jj = 0; jj < 4; ++jj) pk[jj] = cvt_pk_bf16(a[8 * s + 2 * jj], a[8 * s + 2 * jj + 1]);
            const bf16x8 pf = __builtin_bit_cast(bf16x8, pk);
            o[0] = MFMA32(vf[0][s], pf, o[0]);
            o[1] = MFMA32(vf[1][s], pf, o[1]);
        }
        if (sb_done) break;
    }
#pragma unroll
    for (int d = 0; d < 2; ++d)
#pragma unroll
        for (int g = 0; g < 4; ++g) {
            u32x2 pk; pk[0] = cvt_pk_bf16(o[d][4 * g], o[d][4 * g + 1]); pk[1] = cvt_pk_bf16(o[d][4 * g + 2], o[d][4 * g + 3]);
            *(u32x2*)(yp + d * 32 + 8 * g + 4 * h) = pk;
        }
}

DEVINL void swa_task(const Ctx& c, int layer, int b, int qh, int qg) {
    const int lane = TID & 63, r = lane & 31, h = lane >> 5;
    const int q0 = qg * 32, kvh = qh >> 2;
    bf16_t* yp = c.Y() + (size_t)3 * T * 512 + (size_t)(b * L + q0 + r) * 512 + qh * 64;
    if (qg < 3) {
        u32x2 z = {0u, 0u};
#pragma unroll
        for (int d = 0; d < 2; ++d)
#pragma unroll
            for (int g = 0; g < 4; ++g) *(u32x2*)(yp + d * 32 + 8 * g + 4 * h) = z;
        return;
    }
    const bf16_t* zb = c.Z() + (size_t)b * L * ZW;
    bf16x8 qf[4];
    {
        const bf16_t* qp = zb + (size_t)(q0 + r) * ZW + Z_DQ + qh * 64 + 8 * h;
#pragma unroll
        for (int s = 0; s < 4; ++s) qf[s] = *(const bf16x8*)(qp + 16 * s);
    }
    f32x16 o[2];
#pragma unroll
    for (int d = 0; d < 2; ++d)
#pragma unroll
        for (int i = 0; i < 16; ++i) o[d][i] = 0.f;
    const float slope2 = fexp2(-(float)(qh + 1)) * LOG2E;
    float mrun = c.in[I_SINK][layer * 8 + qh] * LOG2E, lrun = 1.f;
    const int qpos = q0 + r;
    const bf16_t* vtb = c.DVT() + (size_t)(b * 128 + kvh * 64 + r) * L + 4 * h;
    const int kt_lo = (qg - 4) > 4 ? (qg - 4) : 4;
    const int ntiles = 1 + (qg >= 4 ? (qg - kt_lo + 1) : 0);
    bf16x8 kfn[4], vfn[2][2];
#define SWA_LOAD(KT) do { const int k0_ = (KT) * 32; const bf16_t* kp_ = zb + (size_t)(k0_ + r) * ZW + Z_DK + kvh * 64 + 8 * h; \
        _Pragma("unroll") for (int s_ = 0; s_ < 4; ++s_) kfn[s_] = *(const bf16x8*)(kp_ + 16 * s_); \
        _Pragma("unroll") for (int d_ = 0; d_ < 2; ++d_) _Pragma("unroll") for (int s_ = 0; s_ < 2; ++s_) { \
            const bf16_t* vp_ = vtb + (size_t)(d_ * 32) * L + k0_ + 16 * s_; const u32x2 lo_ = *(const u32x2*)(vp_), hi_ = *(const u32x2*)(vp_ + 8); \
            u32x4 vv_ = {lo_[0], lo_[1], hi_[0], hi_[1]}; vfn[d_][s_] = __builtin_bit_cast(bf16x8, vv_); } } while (0)
    SWA_LOAD(3);
    for (int it = 0; it < ntiles; ++it) {
        const bool meta = (it == 0);
        const int kt = meta ? 3 : (kt_lo + it - 1);
        const int k0 = kt * 32;
        bf16x8 kf[4], vf[2][2];
#pragma unroll
        for (int s = 0; s < 4; ++s) kf[s] = kfn[s];
#pragma unroll
        for (int d = 0; d < 2; ++d)
#pragma unroll
            for (int s = 0; s < 2; ++s) vf[d][s] = vfn[d][s];
        { const int nk = (it + 1 < ntiles) ? (kt_lo + it) : kt; SWA_LOAD(nk); }
        f32x16 st;
#pragma unroll
        for (int i = 0; i < 16; ++i) st[i] = 0.f;
#pragma unroll
        for (int s = 0; s < 4; ++s) st = MFMA32(kf[s], qf[s], st);
        float sc[16]; float tmax = -INFINITY;
#pragma unroll
        for (int i = 0; i < 16; ++i) {
            const int key = k0 + (i & 3) + 8 * (i >> 2) + 4 * h;
            const int dist = qpos - key;
            const bool ok = meta ? (key >= 112 && dist >= 0) : (dist >= 0 && dist < 128);
            const float v = meta ? st[i] : st[i] - slope2 * (float)dist;
            sc[i] = ok ? v : -INFINITY;
            tmax = fmaxf(tmax, sc[i]);
        }
        tmax = fmaxf(tmax, __shfl_xor(tmax, 32));
        const float mnew = fmaxf(mrun, tmax);
        const float alpha = fexp2(mrun - mnew);
        float psum = 0.f; float pv[16];
#pragma unroll
        for (int i = 0; i < 16; ++i) { pv[i] = fexp2(sc[i] - mnew); psum += pv[i]; }
        psum += __shfl_xor(psum, 32);
        lrun = lrun * alpha + psum; mrun = mnew;
#pragma unroll
        for (int d = 0; d < 2; ++d)
#pragma unroll
            for (int i = 0; i < 16; ++i) o[d][i] *= alpha;
#pragma unroll
        for (int s = 0; s < 2; ++s) {
            u32x4 pk;
#pragma unroll
            for (int jj = 0; jj < 4; ++jj) pk[jj] = cvt_pk_bf16(pv[8 * s + 2 * jj], pv[8 * s + 2 * jj + 1]);
            const bf16x8 pf = __builtin_bit_cast(bf16x8, pk);
            o[0] = MFMA32(vf[0][s], pf, o[0]);
            o[1] = MFMA32(vf[1][s], pf, o[1]);
        }
    }
    const float inv = __builtin_amdgcn_rcpf(lrun);
#pragma unroll
    for (int d = 0; d < 2; ++d)
#pragma unroll
        for (int g = 0; g < 4; ++g) {
            u32x2 pk; pk[0] = cvt_pk_bf16(o[d][4 * g] * inv, o[d][4 * g + 1] * inv); pk[1] = cvt_pk_bf16(o[d][4 * g + 2] * inv, o[d][4 * g + 3] * inv);
            *(u32x2*)(yp + d * 32 + 8 * g + 4 * h) = pk;
        }
}

DEVINL void group_barrier(unsigned* word, unsigned target) {
    asm volatile("s_waitcnt vmcnt(0) lgkmcnt(0)" ::: "memory");
    __syncthreads();
    if (threadIdx.x == 0) {
        __builtin_amdgcn_fence(__ATOMIC_RELEASE, "agent");
        __hip_atomic_fetch_add(word, 1u, __ATOMIC_RELAXED, __HIP_MEMORY_SCOPE_AGENT);
        while (__hip_atomic_load(word, __ATOMIC_RELAXED, __HIP_MEMORY_SCOPE_AGENT) < target) __builtin_amdgcn_s_sleep(2);
        __builtin_amdgcn_fence(__ATOMIC_ACQUIRE, "agent");
        asm volatile("s_waitcnt vmcnt(0)" ::: "memory");
    }
    __syncthreads();
}
DEVINL void partial_merge(const Ctx& c, unsigned char* lds, int idx, int nblk);
DEVINL void phase_mixers(const Ctx& c, int layer, unsigned char* lds) {
    const int bx = BID, G = gridDim.x;
    unsigned* cnts = (unsigned*)(c.ws + WS_END + 1024);
    if (bx < 64) { rwkv_scan(c, layer, bx >> 3, bx & 7, cnts + bx * 3, bx < 32 ? 3 : 2, (float*)lds); return; }
    if (bx < 96) ret_block(c, (bx - 64) >> 2, (bx - 64) & 3, lds);
    else {
        if (bx < 256) {
            const int idx = bx - 96;
            int head, pj, nP;
            if (idx < 96) { head = idx / 3; pj = idx - head * 3; nP = 3; } else { const int j = idx - 96; head = 32 + (j >> 1); pj = j & 1; nP = 2; }
            rw_project_head(c, layer, head >> 3, head & 7, pj, nP, cnts + head * 3 + pj, lds);
        }
        const int nw = (G - 96) * (NTHR / 64), wid = (bx - 96) * (NTHR / 64) + (TID >> 6);
        const int NSB = 68 * 64;
        for (int i = wid; i < 2 * NSB; i += nw) {
            if (i < NSB) { const int qg = 67 - i / 64, bh = i & 63; sb_task(c, bh >> 3, bh & 7, qg); }
            else { const int i2 = i - NSB; const int qg = 67 - i2 / 64, bh = i2 & 63; swa_task(c, layer, bh >> 3, bh & 7, qg); }
        }
    }
    group_barrier((unsigned*)(c.ws + WS_END + 768), (unsigned)((layer + 1) * (G - 64)));
    partial_merge(c, lds, bx - 64, G - 64);
}

DEVINL float* mp_row(const Ctx& c, int t) { return (float*)(c.Z() + (size_t)t * ZW); }
template <int NI, int MODE>
DEVINL void merge_tile(const Ctx& c, unsigned char* lds, int m0, int n0) {
    const int lane = TID & 63, w = TID >> 6, wm = w & 3, wn = w >> 2, r = lane & 31, h = lane >> 5;
    f32x16 mer[NI][2]; zero_acc(mer);
    const int mbase = m0 + wm * 64, nbase = n0 + wn * 32 * NI;
#pragma unroll 1
    for (int bi = 0; bi < (MODE == 0 ? 3 : 1); ++bi) {
        const int br = (MODE == 0) ? (bi == 2 ? 3 : bi) : 2;
        f32x16 acc[NI][2]; zero_acc(acc);
        gemm_kloop<NI>(c.Y() + (size_t)br * T * 512, 512, c.Pbr() + (size_t)br * DM * 512, 512, 512, m0, n0, lds, acc);
#pragma unroll
        for (int mi = 0; mi < 2; ++mi) {
            const bf16_t* gp = c.Z() + (size_t)(mbase + mi * 32 + r) * ZW + Z_GZ + br * DM + nbase;
#pragma unroll
            for (int ni = 0; ni < NI; ++ni)
#pragma unroll
                for (int g = 0; g < 4; ++g) {
                    const u32x2 gg = *(const u32x2*)(gp + ni * 32 + 8 * g + 4 * h);
                    mer[ni][mi][4 * g + 0] += bflo(gg[0]) * acc[ni][mi][4 * g + 0];
                    mer[ni][mi][4 * g + 1] += bfhi(gg[0]) * acc[ni][mi][4 * g + 1];
                    mer[ni][mi][4 * g + 2] += bflo(gg[1]) * acc[ni][mi][4 * g + 2];
                    mer[ni][mi][4 * g + 3] += bfhi(gg[1]) * acc[ni][mi][4 * g + 3];
                }
        }
    }
    if (MODE == 0) {
#pragma unroll
        for (int mi = 0; mi < 2; ++mi) {
            float* pp = mp_row(c, mbase + mi * 32 + r) + nbase;
#pragma unroll
            for (int ni = 0; ni < NI; ++ni)
#pragma unroll
                for (int g = 0; g < 4; ++g) {
                    f32x4 v = {mer[ni][mi][4 * g], mer[ni][mi][4 * g + 1], mer[ni][mi][4 * g + 2], mer[ni][mi][4 * g + 3]};
                    *(f32x4*)(pp + ni * 32 + 8 * g + 4 * h) = v;
                }
        }
        return;
    }
#pragma unroll
    for (int mi = 0; mi < 2; ++mi) {
        const float* pp = mp_row(c, mbase + mi * 32 + r) + nbase;
#pragma unroll
        for (int ni = 0; ni < NI; ++ni)
#pragma unroll
            for (int g = 0; g < 4; ++g) {
                const f32x4 v = *(const f32x4*)(pp + ni * 32 + 8 * g + 4 * h);
#pragma unroll
                for (int j = 0; j < 4; ++j) mer[ni][mi][4 * g + j] += v[j];
            }
    }
    if (NI == 2) {
        u32x2 pkm[2][2][4];
#pragma unroll
        for (int mi = 0; mi < 2; ++mi)
#pragma unroll
            for (int ni = 0; ni < 2; ++ni)
#pragma unroll
                for (int g = 0; g < 4; ++g) { pkm[mi][ni][g][0] = cvt_pk_bf16(mer[ni % NI][mi][4 * g], mer[ni % NI][mi][4 * g + 1]); pkm[mi][ni][g][1] = cvt_pk_bf16(mer[ni % NI][mi][4 * g + 2], mer[ni % NI][mi][4 * g + 3]); }
        store_rows_via_lds(lds, pkm, c.M() + (size_t)mbase * DM + nbase, DM);
    } else {
#pragma unroll
        for (int mi = 0; mi < 2; ++mi) {
            bf16_t* mp = c.M() + (size_t)(mbase + mi * 32 + r) * DM + nbase;
#pragma unroll
            for (int g = 0; g < 4; ++g) {
                u32x2 pk; pk[0] = cvt_pk_bf16(mer[0][mi][4 * g], mer[0][mi][4 * g + 1]); pk[1] = cvt_pk_bf16(mer[0][mi][4 * g + 2], mer[0][mi][4 * g + 3]);
                *(u32x2*)(mp + 8 * g + 4 * h) = pk;
            }
        }
    }
}
DEVINL void partial_merge(const Ctx& c, unsigned char* lds, int idx, int nblk) {
    const int MT = T / 256, NT = DM / 128, total = MT * NT;
    if ((nblk & 7) == 0 && NT == 8) {
        const int x = idx & 7, local = idx >> 3, per = nblk >> 3;
        for (int j = local; ; j += per) {
            const int tm = x + 8 * (j >> 3), tn = j & 7;
            if (tm >= MT) break;
            merge_tile<2, 0>(c, lds, tm * 256, tn * 128);
        }
        return;
    }
    for (int q = idx; q < total; q += nblk) {
        int tm, tn; tile_of(q, MT, NT, tm, tn);
        merge_tile<2, 0>(c, lds, tm * 256, tn * 128);
    }
}
DEVINL void phase_merge(const Ctx& c, unsigned char* lds) {
    const int MT = T / 256, NT = DM / 128, total = MT * NT, G = gridDim.x, slot = slot_of_block();
    const int nfull = (total / G) * G, rem = total - nfull;
    const bool halves = rem > 0 && 2 * rem <= G;
    for (int q = slot; q < (halves ? nfull : total); q += G) {
        int tm, tn; tile_of(q, MT, NT, tm, tn);
        merge_tile<2, 1>(c, lds, tm * 256, tn * 128);
    }
    if (halves && slot < 2 * rem) {
        int tm, tn; tile_of(nfull + (slot >> 1), MT, NT, tm, tn);
        merge_tile<1, 1>(c, lds, tm * 256, tn * 128 + (slot & 1) * 64);
    }
}

template <int NI>
DEVINL void resid_tile(const Ctx& c, const bf16_t* A, int K, const bf16_t* Bt, unsigned char* lds, int m0, int n0, bool dostore) {
    const int lane = TID & 63, w = TID >> 6, wm = w & 3, wn = w >> 2, r = lane & 31, h = lane >> 5;
    f32x16 acc[NI][2]; zero_acc(acc);
    gemm_kloop<NI>(A, K, Bt, K, K, m0, n0, lds, acc);
    const int mbase = m0 + wm * 64, nbase = n0 + wn * 32 * NI;
#pragma unroll
    for (int mi = 0; mi < 2; ++mi) {
        float* xp = xrow(c, mbase + mi * 32 + r) + nbase;
#pragma unroll
        for (int ni = 0; ni < NI; ++ni)
#pragma unroll
            for (int g = 0; g < 4; ++g) {
                f32x4 v = *(f32x4*)(xp + ni * 32 + 8 * g + 4 * h);
#pragma unroll
                for (int j = 0; j < 4; ++j) v[j] += acc[ni][mi][4 * g + j];
                if (dostore || v[0] != v[0]) *(f32x4*)(xp + ni * 32 + 8 * g + 4 * h) = v;
            }
    }
}
DEVINL void phase_gemm_resid(const Ctx& c, const bf16_t* A, int K, const bf16_t* Bt, unsigned char* lds, bool dostore = true) {
    const int MT = T / 256, NT = DM / 128, total = MT * NT, G = gridDim.x, slot = slot_of_block();
    const int nfull = (total / G) * G, rem = total - nfull;
    const bool halves = rem > 0 && 2 * rem <= G;
    for (int q = slot; q < (halves ? nfull : total); q += G) {
        int tm, tn; tile_of(q, MT, NT, tm, tn);
        resid_tile<2>(c, A, K, Bt, lds, tm * 256, tn * 128, dostore);
    }
    if (halves && slot < 2 * rem) {
        int tm, tn; tile_of(nfull + (slot >> 1), MT, NT, tm, tn);
        resid_tile<1>(c, A, K, Bt, lds, tm * 256, tn * 128 + (slot & 1) * 64, dostore);
    }
}

DEVINL void phase_up(const Ctx& c, unsigned char* lds) {
    const int MT = T / 256, NT = DFF / 128, total = MT * NT;
    const int lane = TID & 63, w = TID >> 6, wm = w & 3, wn = w >> 2, r = lane & 31, h = lane >> 5;
    for (int q = slot_of_block(); q < total; q += gridDim.x) {
        int tm, tn; tile_of(q, MT, NT, tm, tn);
        f32x16 acc[2][2]; zero_acc(acc);
        gemm_kloop(c.H(), DM, c.Wup(), DM, DM, tm * 256, tn * 128, lds, acc);
        const int mbase = tm * 256 + wm * 64, nbase = tn * 128 + wn * 64;
        {
            u32x2 pku[2][2][4];
#pragma unroll
            for (int mi = 0; mi < 2; ++mi)
#pragma unroll
                for (int ni = 0; ni < 2; ++ni)
#pragma unroll
                    for (int g = 0; g < 4; ++g) {
                        float v[4];
#pragma unroll
                        for (int j = 0; j < 4; ++j) { const float a = fmaxf(acc[ni][mi][4 * g + j], 0.f); v[j] = a * a; }
                        pku[mi][ni][g][0] = cvt_pk_bf16(v[0], v[1]); pku[mi][ni][g][1] = cvt_pk_bf16(v[2], v[3]);
                    }
            store_rows_via_lds(lds, pku, c.U() + (size_t)mbase * DFF + nbase, DFF);
        }
    }
}

DEVINL void grid_barrier(unsigned* bar, unsigned epoch) {
    asm volatile("s_waitcnt vmcnt(0) lgkmcnt(0)" ::: "memory");
    __syncthreads();
    if (threadIdx.x == 0) {
        __builtin_amdgcn_fence(__ATOMIC_RELEASE, "agent");
        const unsigned G = gridDim.x;
        if ((G & 7u) == 0u) {
            const unsigned g = blockIdx.x & 7u, ng = G >> 3;
            const unsigned old = __hip_atomic_fetch_add(bar + 16 * (1 + g), 1u, __ATOMIC_RELAXED, __HIP_MEMORY_SCOPE_AGENT);
            if (old + 1u == epoch * ng) __hip_atomic_fetch_add(bar, 1u, __ATOMIC_RELAXED, __HIP_MEMORY_SCOPE_AGENT);
            while (__hip_atomic_load(bar, __ATOMIC_RELAXED, __HIP_MEMORY_SCOPE_AGENT) < epoch * 8u) __builtin_amdgcn_s_sleep(1);
        } else {
            __hip_atomic_fetch_add(bar, 1u, __ATOMIC_RELAXED, __HIP_MEMORY_SCOPE_AGENT);
            while (__hip_atomic_load(bar, __ATOMIC_RELAXED, __HIP_MEMORY_SCOPE_AGENT) < epoch * G) __builtin_amdgcn_s_sleep(1);
        }
        __builtin_amdgcn_fence(__ATOMIC_ACQUIRE, "agent");
        asm volatile("s_waitcnt vmcnt(0)" ::: "memory");
    }
    __syncthreads();
}

constexpr int LDS_BYTES = 3 * STAGE;
constexpr int PH_PER_LAYER = 8, N_PHASES = 1 + DEPTH * PH_PER_LAYER;

__global__ void __launch_bounds__(NTHR) fwd_megakernel(Params P) {
    extern __shared__ __attribute__((aligned(16))) unsigned char lds[];
    cg::grid_group grid = cg::this_grid();
    Ctx c;
    c.in = P.in; c.ws = P.ws; c.out = P.out;
    const int lo = P.ph_lo, hi = P.ph_hi;
    unsigned epoch = 0;
    if (hi < 0) grid.sync();
    for (int ph = lo; ph < hi; ++ph) {
        if (ph == 0) phase_init(c);
        else {
            const int layer = (ph - 1) / PH_PER_LAYER, sub = (ph - 1) % PH_PER_LAYER;
#ifdef PROBE_SUB
#define PROBE_LAST (rep == ((sub == PROBE_SUB || PROBE_SUB == 99) ? 1 : 0))
            for (int rep = 0; rep < ((sub == PROBE_SUB || PROBE_SUB == 99) ? 2 : 1); ++rep)
#else
#define PROBE_LAST true
#endif
            switch (sub) {
                case 0: phase_norm(c, c.in[I_N1G] + layer * DM, true); phase_cvt(c, layer, (float*)lds); break;
                case 1:
#ifdef PROBE_TRIV
                    phase_inproj(c, layer, lds, true);
#endif
                    phase_inproj(c, layer, lds); break;
                case 2: phase_mixers(c, layer, lds); break;
                case 3: phase_merge(c, lds); break;
                case 4: phase_gemm_resid(c, c.M(), DM, c.Wo(), lds, PROBE_LAST); break;
                case 5: phase_norm(c, c.in[I_N2G] + layer * DM, false); break;
                case 6: phase_up(c, lds); break;
                case 7: phase_gemm_resid(c, c.U(), DFF, c.Wdn(), lds, PROBE_LAST); break;
            }
        }
        if (ph + 1 < hi) {
#if MULTI_LAUNCH
            grid.sync();
#else
#ifdef PROBE_BAR
            for (int rb = 0; rb < PROBE_BAR; ++rb) grid_barrier((unsigned*)(c.ws + WS_END), ++epoch);
#endif
            grid_barrier((unsigned*)(c.ws + WS_END), ++epoch);
#endif
        }
    }
}

extern "C" void kernel_launch(void* const* d_in, const int* in_sizes, int n_in, void* d_out, int out_size, void* d_ws, size_t ws_size, hipStream_t stream) {
    static int grid_blocks = 0;
    if (!grid_blocks) {
        int dev = 0, cus = 0, per_cu = 0;
        hipGetDevice(&dev);
        hipDeviceGetAttribute(&cus, hipDeviceAttributeMultiprocessorCount, dev);
        hipFuncSetAttribute((const void*)fwd_megakernel, hipFuncAttributeMaxDynamicSharedMemorySize, LDS_BYTES);
        hipOccupancyMaxActiveBlocksPerMultiprocessor(&per_cu, (const void*)fwd_megakernel, NTHR, LDS_BYTES);
        if (per_cu < 1) per_cu = 1;
        grid_blocks = cus * per_cu;
        if (grid_blocks > 256) grid_blocks = 256;
        if (ws_size < WS_END) fprintf(stderr, "kernel_launch: workspace too small: %zu < %zu\n", ws_size, (size_t)WS_END);
        if (n_in != N_INPUTS) fprintf(stderr, "kernel_launch: expected %d inputs, got %d\n", (int)N_INPUTS, n_in);
    }
    Params p{};
    for (int i = 0; i < N_INPUTS; ++i) p.in[i] = (const float*)d_in[i];
    p.out = (float*)d_out; p.ws = (unsigned char*)d_ws;
#if MULTI_LAUNCH
    for (int ph = 0; ph < N_PHASES; ++ph) {
        p.ph_lo = ph; p.ph_hi = ph + 1;
        hipLaunchKernelGGL(fwd_megakernel, dim3(grid_blocks), dim3(NTHR), LDS_BYTES, stream, p);
    }
#else
    p.ph_lo = 0; p.ph_hi = N_PHASES;
    hipMemsetAsync((unsigned char*)d_ws + WS_END, 0, 2048, stream);
    void* args[] = {&p};
    hipError_t e = hipLaunchCooperativeKernel((const void*)fwd_megakernel, dim3(grid_blocks), dim3(NTHR), args, LDS_BYTES, stream);
    if (e != hipSuccess) fprintf(stderr, "cooperative launch failed: %s (grid %d)\n", hipGetErrorString(e), grid_blocks);
#endif
}
```

```cpp
#include <hip/hip_runtime.h>
#include <hip/hip_cooperative_groups.h>
#include <cstdio>
namespace cg = cooperative_groups;

typedef unsigned short bf16_t;
typedef short bf16x8 __attribute__((ext_vector_type(8)));
typedef float f32x16 __attribute__((ext_vector_type(16)));
typedef float f32x4 __attribute__((ext_vector_type(4)));
typedef unsigned u32x2 __attribute__((ext_vector_type(2)));
typedef unsigned u32x4 __attribute__((ext_vector_type(4)));

#define DEVINL __device__ __forceinline__
#define MFMA32(a, b, c) __builtin_amdgcn_mfma_f32_32x32x16_bf16((a), (b), (c), 0, 0, 0)

constexpr int NB = 8, SEQ = 2048, L = 2176, T = NB * L, DM = 1024, DEPTH = 4;
constexpr int NZP = 9856, ZW = 8704, DFF = 4096;
constexpr int NTHR = 512;
#define MULTI_LAUNCH 0
constexpr int Z_AQ = 0, Z_AK = 512, Z_BQ = 1024, Z_BK = 1280, Z_BG = 1536, Z_C = 2048, Z_DQ = 3840, Z_DK = 4352, Z_GZ = 4480, Z_VL = 8576;
constexpr float LOG2E = 1.4426950408889634f;
constexpr float QS = 0.125f * LOG2E;

enum { I_X = 0, I_META, I_N1G, I_WIN, I_MU, I_W0, I_W2, I_A0, I_A2, I_G2, I_KKW, I_KAW, I_RK, I_LNG, I_LNB, I_V0, I_V1, I_V2,
       I_QNG, I_KNG, I_SINK, I_PSB, I_PRET, I_PRW, I_PSW, I_WO, I_N2G, I_WUP, I_WDN, N_INPUTS };

constexpr size_t SZ_WIN = (size_t)NZP * DM * 2, SZ_PBR = (size_t)4 * DM * 512 * 2, SZ_WO = (size_t)DM * DM * 2, SZ_WUP = (size_t)DFF * DM * 2, SZ_WDN = SZ_WUP;
constexpr size_t SZ_Z = (size_t)T * ZW * 2, SZ_A512 = (size_t)T * 512 * 2;
constexpr size_t OFF_WIN = 0, OFF_PBR = OFF_WIN + SZ_WIN, OFF_WO = OFF_PBR + SZ_PBR, OFF_WUP = OFF_WO + SZ_WO, OFF_WDN = OFF_WUP + SZ_WUP,
                 OFF_Z = OFF_WDN + SZ_WDN, OFF_AVT = OFF_Z + SZ_Z, OFF_BVT = OFF_AVT + SZ_A512, OFF_DVT = OFF_BVT + SZ_A512,
                 OFF_BKT = OFF_DVT + (size_t)T * 128 * 2, OFF_RW = OFF_BKT + (size_t)T * 256 * 2, OFF_Y = OFF_RW + 7 * SZ_A512,
                 OFF_VF = OFF_Y + 4 * SZ_A512, OFF_XL = OFF_VF + SZ_A512, WS_END = OFF_XL + (size_t)NB * 128 * DM * 4;

struct Params {
    const float* in[N_INPUTS];
    float* out;
    unsigned char* ws;
    int ph_lo, ph_hi;
};

struct Ctx {
    const float* const* in;
    unsigned char* ws;
    float* out;
    DEVINL bf16_t* Win() const { return (bf16_t*)(ws + OFF_WIN); }
    DEVINL bf16_t* Pbr() const { return (bf16_t*)(ws + OFF_PBR); }
    DEVINL bf16_t* Wo() const { return (bf16_t*)(ws + OFF_WO); }
    DEVINL bf16_t* Wup() const { return (bf16_t*)(ws + OFF_WUP); }
    DEVINL bf16_t* Wdn() const { return (bf16_t*)(ws + OFF_WDN); }
    DEVINL bf16_t* Z() const { return (bf16_t*)(ws + OFF_Z); }
    DEVINL bf16_t* U() const { return (bf16_t*)(ws + OFF_Z); }
    DEVINL bf16_t* AVT() const { return (bf16_t*)(ws + OFF_AVT); }
    DEVINL bf16_t* BVT() const { return (bf16_t*)(ws + OFF_BVT); }
    DEVINL bf16_t* DVT() const { return (bf16_t*)(ws + OFF_DVT); }
    DEVINL bf16_t* BKT() const { return (bf16_t*)(ws + OFF_BKT); }
    DEVINL bf16_t* RW() const { return (bf16_t*)(ws + OFF_RW); }
    DEVINL bf16_t* H() const { return (bf16_t*)(ws + OFF_RW); }
    DEVINL bf16_t* M() const { return (bf16_t*)(ws + OFF_RW + 2 * SZ_A512); }
    DEVINL bf16_t* Y() const { return (bf16_t*)(ws + OFF_Y); }
    DEVINL bf16_t* VF() const { return (bf16_t*)(ws + OFF_VF); }
    DEVINL float* xlead() const { return (float*)(ws + OFF_XL); }
};

DEVINL int opq_v(int x) { asm volatile("" : "+v"(x)); return x; }
DEVINL int opq_s(int x) { asm volatile("" : "+s"(x)); return x; }
#define TID (opq_v((int)threadIdx.x))
#define BID (opq_s((int)blockIdx.x))
typedef float f32x2 __attribute__((ext_vector_type(2)));
typedef __bf16 bf16x2v __attribute__((ext_vector_type(2)));
DEVINL unsigned cvt_pk_bf16(float lo, float hi) { const f32x2 v = {lo, hi}; return __builtin_bit_cast(unsigned, __builtin_convertvector(v, bf16x2v)); }
DEVINL bf16_t f2bf(float f) { return (bf16_t)(cvt_pk_bf16(f, 0.f) & 0xffffu); }
DEVINL float bf2f(bf16_t v) { return __uint_as_float(((unsigned)v) << 16); }
DEVINL float bflo(unsigned u) { return __uint_as_float(u << 16); }
DEVINL float bfhi(unsigned u) { return __uint_as_float(u & 0xffff0000u); }
DEVINL float fexp2(float x) { return __builtin_amdgcn_exp2f(x); }
DEVINL float flog2(float x) { return __builtin_amdgcn_logf(x); }
DEVINL float sigmoidf_(float x) { return __builtin_amdgcn_rcpf(1.f + fexp2(-x * LOG2E)); }
DEVINL float wave_sum(float v) {
#pragma unroll
    for (int o = 32; o >= 1; o >>= 1) v += __shfl_xor(v, o);
    return v;
}
#define DPPF(v, ctrl) __int_as_float(__builtin_amdgcn_update_dpp(0, __float_as_int(v), (ctrl), 0xF, 0xF, true))
DEVINL float wave_sum_dpp(float v) {
    v += DPPF(v, 0xB1); v += DPPF(v, 0x4E); v += DPPF(v, 0x141); v += DPPF(v, 0x140);
    const int iv = __float_as_int(v);
    return (__int_as_float(__builtin_amdgcn_readlane(iv, 0)) + __int_as_float(__builtin_amdgcn_readlane(iv, 16))) +
           (__int_as_float(__builtin_amdgcn_readlane(iv, 32)) + __int_as_float(__builtin_amdgcn_readlane(iv, 48)));
}
DEVINL float quad_sum(float v) {
    v += __int_as_float(__builtin_amdgcn_update_dpp(0, __float_as_int(v), 0xB1, 0xF, 0xF, true));
    v += __int_as_float(__builtin_amdgcn_update_dpp(0, __float_as_int(v), 0x4E, 0xF, 0xF, true));
    return v;
}
DEVINL float* xrow(const Ctx& c, int t) {
    const int b = t / L, p = t - b * L;
    return p < 128 ? c.xlead() + (size_t)(b * 128 + p) * DM : c.out + ((size_t)b * SEQ + (p - 128)) * DM;
}
DEVINL int slot_of_block() {
    const int G = gridDim.x, bx = BID;
    return (G % 8 == 0) ? (bx % 8) * (G / 8) + bx / 8 : bx;
}
#ifndef TILE_GW
#define TILE_GW 8
#endif
DEVINL void tile_of(int q, int MT, int NT, int& m, int& n) {
    const int per = MT * TILE_GW, ng = q / per, rem = q - ng * per;
    int nw = NT - ng * TILE_GW; nw = nw > TILE_GW ? TILE_GW : nw;
    m = rem / nw; n = ng * TILE_GW + rem % nw;
}

DEVINL void phase_init(const Ctx& c) {
    const float* x = c.in[I_X]; const float* meta = c.in[I_META];
    const int total = T * (DM / 4);
    for (int idx = BID * NTHR + TID; idx < total; idx += gridDim.x * NTHR) {
        const int t = idx >> 8, c4 = (idx & 255) * 4;
        const int b = t / L, p = t - b * L;
        f32x4 v = {0.f, 0.f, 0.f, 0.f};
        if (p >= 128) v = *(const f32x4*)(x + ((size_t)b * SEQ + (p - 128)) * DM + c4);
        else if (p >= 112) v = *(const f32x4*)(meta + (size_t)(p - 112) * DM + c4);
        *(f32x4*)(xrow(c, t) + c4) = v;
    }
}

DEVINL void cvt_mat(const float* __restrict__ src, int K, int N, bf16_t* __restrict__ dst, float* lds) {
    const int kt = K / 64, ntl = (N + 63) / 64, total = kt * ntl;
    const int tid = TID, G = gridDim.x;
    float v[8];
    int tile = BID;
    if (tile < total) {
        const int k0 = (tile / ntl) * 64, n0 = (tile % ntl) * 64;
#pragma unroll
        for (int i = 0; i < 8; ++i) { const int e = tid + i * NTHR, k = e >> 6, n = e & 63; v[i] = (n0 + n < N) ? src[(size_t)(k0 + k) * N + n0 + n] : 0.f; }
    }
    for (; tile < total; tile += G) {
        const int k0 = (tile / ntl) * 64, n0 = (tile % ntl) * 64;
        __syncthreads();
#pragma unroll
        for (int i = 0; i < 8; ++i) { const int e = tid + i * NTHR; lds[(e >> 6) * 65 + (e & 63)] = v[i]; }
        __syncthreads();
        if (tile + G < total) {
            const int t2 = tile + G, k2 = (t2 / ntl) * 64, n2 = (t2 % ntl) * 64;
#pragma unroll
            for (int i = 0; i < 8; ++i) { const int e = tid + i * NTHR, k = e >> 6, n = e & 63; v[i] = (n2 + n < N) ? src[(size_t)(k2 + k) * N + n2 + n] : 0.f; }
        }
        for (int e = tid; e < 2048; e += NTHR) {
            const int n = e >> 5, kk = (e & 31) * 2;
            if (n0 + n < N) *(unsigned*)(dst + (size_t)(n0 + n) * K + k0 + kk) = cvt_pk_bf16(lds[kk * 65 + n], lds[(kk + 1) * 65 + n]);
        }
    }
}
DEVINL void phase_cvt(const Ctx& c, int l, float* lds) {
    cvt_mat(c.in[I_WIN] + (size_t)l * DM * 9728, DM, 9728, c.Win(), lds);
    if (l > 0) cvt_mat(c.in[I_V1] + (size_t)(l - 1) * DM * 32, DM, 32, c.Win() + (size_t)9728 * DM, lds);
    {
        const int r0 = 9728 + (l > 0 ? 32 : 0), n = (NZP - r0) * DM / 8;
        u32x4 z = {0u, 0u, 0u, 0u};
        for (int i = BID * NTHR + TID; i < n; i += gridDim.x * NTHR) *(u32x4*)(c.Win() + (size_t)r0 * DM + (size_t)i * 8) = z;
    }
    cvt_mat(c.in[I_PSB] + (size_t)l * 512 * DM, 512, DM, c.Pbr(), lds);
    cvt_mat(c.in[I_PRET] + (size_t)l * 512 * DM, 512, DM, c.Pbr() + (size_t)DM * 512, lds);
    cvt_mat(c.in[I_PRW] + (size_t)l * 512 * DM, 512, DM, c.Pbr() + (size_t)2 * DM * 512, lds);
    cvt_mat(c.in[I_PSW] + (size_t)l * 512 * DM, 512, DM, c.Pbr() + (size_t)3 * DM * 512, lds);
    cvt_mat(c.in[I_WO] + (size_t)l * DM * DM, DM, DM, c.Wo(), lds);
    cvt_mat(c.in[I_WUP] + (size_t)l * DM * DFF, DM, DFF, c.Wup(), lds);
    cvt_mat(c.in[I_WDN] + (size_t)l * DFF * DM, DFF, DM, c.Wdn(), lds);
}

DEVINL void phase_norm(const Ctx& c, const float* __restrict__ g, bool mask_pads) {
    const int lane = TID & 63, wid = (BID * NTHR + TID) >> 6, nw = gridDim.x * (NTHR / 64);
    f32x4 gv[4];
#pragma unroll
    for (int i = 0; i < 4; ++i) gv[i] = *(const f32x4*)(g + i * 256 + lane * 4);
    for (int t = wid; t < T; t += nw) {
        const int p = t % L;
        bf16_t* hp = c.H() + (size_t)t * DM;
        if (mask_pads && p < 112) {
            u32x2 z = {0u, 0u};
#pragma unroll
            for (int i = 0; i < 4; ++i) *(u32x2*)(hp + i * 256 + lane * 4) = z;
            continue;
        }
        const float* xp = xrow(c, t);
        f32x4 v[4]; float ss = 0.f;
#pragma unroll
        for (int i = 0; i < 4; ++i) { v[i] = *(const f32x4*)(xp + i * 256 + lane * 4); ss += v[i][0] * v[i][0] + v[i][1] * v[i][1] + v[i][2] * v[i][2] + v[i][3] * v[i][3]; }
        ss = wave_sum(ss);
        const float rs = rsqrtf(ss * (1.f / DM) + 1e-6f);
#pragma unroll
        for (int i = 0; i < 4; ++i) {
            u32x2 o; o[0] = cvt_pk_bf16(v[i][0] * rs * gv[i][0], v[i][1] * rs * gv[i][1]); o[1] = cvt_pk_bf16(v[i][2] * rs * gv[i][2], v[i][3] * rs * gv[i][3]);
            *(u32x2*)(hp + i * 256 + lane * 4) = o;
        }
    }
}

#define LAS __attribute__((address_space(3)))
constexpr int LROW = 144;
constexpr int A_ST = 256 * 128, B_ST = 128 * 128, STAGE = A_ST + B_ST;
template <int NI>
DEVINL void gemm_kloop(const bf16_t* __restrict__ A, int lda, const bf16_t* __restrict__ Bt, int ldb, int K, int m0, int n0,
                       unsigned char* lds, f32x16 (&acc)[NI][2]) {
    const int tid = TID, lane = tid & 63, w = tid >> 6, wm = w & 3, wn = w >> 2, r = lane & 31, h = lane >> 5;
    const int lrow = tid >> 3, cg = (tid & 7) ^ ((tid >> 4) & 7);
    const bf16_t* ga = A + (size_t)(m0 + lrow) * lda + cg * 8;
    const bf16_t* gb = Bt + (size_t)(n0 + lrow) * ldb + cg * 8;
    unsigned char* da = lds + tid * 16;
    unsigned char* db = lds + A_ST + tid * 16;
#define GEMM_ISSUE(stg, kt) do { const int k0_ = (kt) * 64; \
        _Pragma("unroll") for (int i = 0; i < 4; ++i) __builtin_amdgcn_global_load_lds((const void*)(ga + (size_t)(i * 64) * lda + k0_), (LAS void*)(da + (stg) * STAGE + i * 8192), 16, 0, 0); \
        _Pragma("unroll") for (int i = 0; i < NI; ++i) __builtin_amdgcn_global_load_lds((const void*)(gb + (size_t)(i * 64) * ldb + k0_), (LAS void*)(db + (stg) * STAGE + i * 8192), 16, 0, 0); } while (0)
    const int nt = K >> 6;
    asm volatile("s_waitcnt lgkmcnt(0)" ::: "memory");
    __builtin_amdgcn_s_barrier();
    GEMM_ISSUE(0, 0);
    if (nt > 1) GEMM_ISSUE(1, 1);
    const int sw = (r >> 1) & 7;
    int o4[4];
#pragma unroll
    for (int ks = 0; ks < 4; ++ks) o4[ks] = ((ks * 2 + h) ^ sw) * 16;
    int cur = 0;
    auto compute = [&](int st_) {
        const unsigned char* pa = lds + st_ * STAGE + (wm * 64 + r) * 128;
        const unsigned char* pb = lds + st_ * STAGE + A_ST + (wn * 32 * NI + r) * 128;
        bf16x8 af[2][2], bfr[2][NI];
#pragma unroll
        for (int i = 0; i < 2; ++i) af[0][i] = *(const bf16x8*)(pa + i * 32 * 128 + o4[0]);
#pragma unroll
        for (int i = 0; i < NI; ++i) bfr[0][i] = *(const bf16x8*)(pb + i * 32 * 128 + o4[0]);
#pragma unroll
        for (int ks = 0; ks < 4; ++ks) {
            if (ks < 3) {
#pragma unroll
                for (int i = 0; i < 2; ++i) af[(ks + 1) & 1][i] = *(const bf16x8*)(pa + i * 32 * 128 + o4[ks + 1]);
#pragma unroll
                for (int i = 0; i < NI; ++i) bfr[(ks + 1) & 1][i] = *(const bf16x8*)(pb + i * 32 * 128 + o4[ks + 1]);
            }
#pragma unroll
            for (int ni = 0; ni < NI; ++ni)
#pragma unroll
                for (int mi = 0; mi < 2; ++mi) acc[ni][mi] = MFMA32(bfr[ks & 1][ni], af[ks & 1][mi], acc[ni][mi]);
        }
    };
    int t = 0;
    for (; t + 2 < nt; ++t) {
        if (NI == 2) asm volatile("s_waitcnt vmcnt(6)" ::: "memory"); else asm volatile("s_waitcnt vmcnt(5)" ::: "memory");
        __builtin_amdgcn_s_barrier();
        { const int s2 = (cur >= 1) ? cur - 1 : 2; GEMM_ISSUE(s2, t + 2); }
        compute(cur);
        cur = (cur == 2) ? 0 : cur + 1;
    }
    if (nt >= 2) {
        if (NI == 2) asm volatile("s_waitcnt vmcnt(6)" ::: "memory"); else asm volatile("s_waitcnt vmcnt(5)" ::: "memory");
        __builtin_amdgcn_s_barrier();
        compute(cur);
        cur = (cur == 2) ? 0 : cur + 1;
    }
    asm volatile("s_waitcnt vmcnt(0)" ::: "memory");
    __builtin_amdgcn_s_barrier();
    compute(cur);
#undef GEMM_ISSUE
}
template <int NA>
DEVINL void zero_acc(f32x16 (&acc)[NA][2]) {
#pragma unroll
    for (int a = 0; a < NA; ++a)
#pragma unroll
        for (int b = 0; b < 2; ++b)
#pragma unroll
            for (int i = 0; i < 16; ++i) acc[a][b][i] = 0.f;
}


DEVINL void store_rows_via_lds(unsigned char* lds, const u32x2 (&pk)[2][2][4], bf16_t* out_row0, int ld) {
    const int tid = TID, lane = tid & 63, w = tid >> 6, r = lane & 31, h = lane >> 5;
    unsigned char* reg = lds + w * (64 * 144);
    __syncthreads();
#pragma unroll
    for (int mi = 0; mi < 2; ++mi)
#pragma unroll
        for (int ni = 0; ni < 2; ++ni)
#pragma unroll
            for (int g = 0; g < 4; ++g) *(u32x2*)(reg + (mi * 32 + r) * 144 + (ni * 32 + 8 * g + 4 * h) * 2) = pk[mi][ni][g];
    __syncthreads();
#pragma unroll
    for (int it = 0; it < 8; ++it) {
        const int idx = it * 64 + lane, row = idx >> 3, c16 = idx & 7;
        const u32x4 v = *(const u32x4*)(reg + row * 144 + c16 * 16);
        *(u32x4*)(out_row0 + (size_t)row * ld + c16 * 8) = v;
    }
}


DEVINL void store_cols_via_lds(unsigned char* lds, const u32x2 (&pk)[2][2][4], bf16_t* vt_col0  ) {
    const int tid = TID, lane = tid & 63, w = tid >> 6, r = lane & 31, h = lane >> 5;
    unsigned char* reg = lds + w * (64 * 144);
    __syncthreads();
#pragma unroll
    for (int mi = 0; mi < 2; ++mi)
#pragma unroll
        for (int ni = 0; ni < 2; ++ni)
#pragma unroll
            for (int g = 0; g < 4; ++g) {
                const int n = ni * 32 + 8 * g + 4 * h, m = mi * 32 + r;
                *(bf16_t*)(reg + (n + 0) * 144 + m * 2) = (bf16_t)(pk[mi][ni][g][0] & 0xffffu);
                *(bf16_t*)(reg + (n + 1) * 144 + m * 2) = (bf16_t)(pk[mi][ni][g][0] >> 16);
                *(bf16_t*)(reg + (n + 2) * 144 + m * 2) = (bf16_t)(pk[mi][ni][g][1] & 0xffffu);
                *(bf16_t*)(reg + (n + 3) * 144 + m * 2) = (bf16_t)(pk[mi][ni][g][1] >> 16);
            }
    __syncthreads();
#pragma unroll
    for (int it = 0; it < 8; ++it) {
        const int idx = it * 64 + lane, n = idx >> 3, c16 = idx & 7;
        const u32x4 v = *(const u32x4*)(reg + n * 144 + c16 * 16);
        *(u32x4*)(vt_col0 + (size_t)n * L + c16 * 8) = v;
    }
}

DEVINL void epi_inproj(const Ctx& c, int layer, f32x16 (&acc)[2][2], int mbase, int nbase, unsigned char* lds) {
    const int lane = TID & 63, r = lane & 31, h = lane >> 5;
    const int n = nbase;
    int zc = -1, tr = 0, vcol = 0, vC = 0; bf16_t* vt = nullptr; float scale = 1.f; const float* gain = nullptr;
    if (n < 512) { zc = Z_AQ + n; scale = QS; }
    else if (n < 1024) { zc = Z_AK + (n - 512); }
    else if (n < 1536) { vt = c.AVT(); vcol = n - 1024; vC = 512; }
    else if (n < 1792) { zc = Z_BQ + (n - 1536); }
    else if (n < 2048) { zc = Z_BK + (n - 1792); scale = 0.125f; vt = c.BKT(); vcol = n - 1792; vC = 256; }
    else if (n < 2560) { vt = c.BVT(); vcol = n - 2048; vC = 512; }
    else if (n < 3072) { zc = Z_BG + (n - 2560); }
    else if (n < 4864) { zc = Z_C + (n - 3072); }
    else if (n < 5376) { zc = Z_DQ + (n - 4864); tr = 1; scale = QS; gain = c.in[I_QNG] + layer * 64; }
    else if (n < 5504) { zc = Z_DK + (n - 5376); tr = 1; gain = c.in[I_KNG] + layer * 64; }
    else if (n < 5632) { vt = c.DVT(); vcol = n - 5504; vC = 128; }
    else if (n < 9728) { zc = Z_GZ + (n - 5632); tr = 2; }
    else { zc = Z_VL + (n - 9728); }
    u32x2 pkz[2][2][4];
#pragma unroll
    for (int mi = 0; mi < 2; ++mi) {
        const int m = mbase + mi * 32 + r;
        const int b = m / L, p = m - b * L;
        float rs = scale;
        if (tr == 1) {
            float ss = 0.f;
#pragma unroll
            for (int ni = 0; ni < 2; ++ni)
#pragma unroll
                for (int i = 0; i < 16; ++i) ss += acc[ni][mi][i] * acc[ni][mi][i];
            ss += __shfl_xor(ss, 32);
            rs = rsqrtf(ss * (1.f / 64.f) + 1e-6f) * scale;
        }
#pragma unroll
        for (int ni = 0; ni < 2; ++ni)
#pragma unroll
            for (int g = 0; g < 4; ++g) {
                const int nl = ni * 32 + 8 * g + 4 * h;
                float v[4];
#pragma unroll
                for (int j = 0; j < 4; ++j) v[j] = acc[ni][mi][4 * g + j];
                if (tr == 1) {
                    const f32x4 gg = *(const f32x4*)(gain + nl);
#pragma unroll
                    for (int j = 0; j < 4; ++j) v[j] *= rs * gg[j];
                } else if (tr == 2) {
#pragma unroll
                    for (int j = 0; j < 4; ++j) v[j] = sigmoidf_(v[j]);
                } else {
#pragma unroll
                    for (int j = 0; j < 4; ++j) v[j] *= scale;
                }
                { u32x2 o; o[0] = cvt_pk_bf16(v[0], v[1]); o[1] = cvt_pk_bf16(v[2], v[3]); pkz[mi][ni][g] = o; }
            }
    }
    if (zc >= 0) store_rows_via_lds(lds, pkz, c.Z() + (size_t)mbase * ZW + zc, ZW);
    if (vt) { const int b0 = mbase / L, p0 = mbase - b0 * L; store_cols_via_lds(lds, pkz, vt + ((size_t)(b0 * vC + vcol)) * L + p0); }
}
DEVINL void phase_inproj(const Ctx& c, int layer, unsigned char* lds, bool trivial = false) {
    const int MT = T / 256, NT = NZP / 128, total = MT * NT;
    const int w = TID >> 6, wm = w & 3, wn = w >> 2;
    const int G = gridDim.x, slot = slot_of_block();
    const int nfull = (total / G) * G, rem = total - nfull;
    bool halves = rem > 0 && 2 * rem <= G && !trivial;
    if (halves) { int tm0, tn0; tile_of(nfull, MT, NT, tm0, tn0); halves = tn0 >= 44; }
    if (halves && slot < 2 * rem) {
        int tm, tn; tile_of(nfull + (slot >> 1), MT, NT, tm, tn);
        const int lane = TID & 63, r = lane & 31, h = lane >> 5;
        const int n0 = tn * 128 + (slot & 1) * 64;
        f32x16 acc1[1][2]; zero_acc(acc1);
        gemm_kloop<1>(c.H(), DM, c.Win(), DM, DM, tm * 256, n0, lds, acc1);
        const int mbase = tm * 256 + wm * 64, nb = n0 + wn * 32;
        const bool sig = nb < 9728;
        const int zc = sig ? Z_GZ + (nb - 5632) : Z_VL + (nb - 9728);
#pragma unroll
        for (int mi = 0; mi < 2; ++mi) {
            bf16_t* zp = c.Z() + (size_t)(mbase + mi * 32 + r) * ZW + zc;
#pragma unroll
            for (int g = 0; g < 4; ++g) {
                float v[4];
#pragma unroll
                for (int j = 0; j < 4; ++j) { const float a = acc1[0][mi][4 * g + j]; v[j] = sig ? sigmoidf_(a) : a; }
                u32x2 o; o[0] = cvt_pk_bf16(v[0], v[1]); o[1] = cvt_pk_bf16(v[2], v[3]);
                *(u32x2*)(zp + 8 * g + 4 * h) = o;
            }
        }
    }
    for (int q = slot; q < (halves ? nfull : total); q += G) {
        int tm, tn; tile_of(q, MT, NT, tm, tn);
        f32x16 acc[2][2]; zero_acc(acc);
        gemm_kloop<2>(c.H(), DM, c.Win(), DM, DM, tm * 256, tn * 128, lds, acc);
        if (trivial) {
            const int lane = TID & 63, r = lane & 31, h = lane >> 5;
            u32x2 pk[2][2][4];
#pragma unroll
            for (int mi = 0; mi < 2; ++mi)
#pragma unroll
                for (int ni = 0; ni < 2; ++ni)
#pragma unroll
                    for (int g = 0; g < 4; ++g) { pk[mi][ni][g][0] = cvt_pk_bf16(acc[ni][mi][4 * g], acc[ni][mi][4 * g + 1]); pk[mi][ni][g][1] = cvt_pk_bf16(acc[ni][mi][4 * g + 2], acc[ni][mi][4 * g + 3]); }
            const int zc = (tn < 68 ? tn : tn - 9) * 128 + wn * 64;
            store_rows_via_lds(lds, pk, c.Z() + (size_t)(tm * 256 + wm * 64) * ZW + zc, ZW);
        } else
        epi_inproj(c, layer, acc, tm * 256 + wm * 64, tn * 128 + wn * 64, lds);
    }
}

DEVINL void phase_rwproj(const Ctx& c, int layer, float* act) {
    const int tid = TID, col = tid;
    const float* mu = c.in[I_MU] + layer * 1792;
    const float mu_r = mu[col], mu_k = mu[512 + col], mu_v = mu[1024 + col];
    const float w0c = c.in[I_W0][layer * 512 + col], a0c = c.in[I_A0][layer * 512 + col];
    const float kkc = c.in[I_KKW][layer * 512 + col], kac = c.in[I_KAW][layer * 512 + col];
    const float v0c = layer > 0 ? c.in[I_V0][(layer - 1) * 512 + col] : 0.f;
    const float* w2 = c.in[I_W2] + (size_t)layer * 64 * 512 + col;
    const float* a2 = c.in[I_A2] + (size_t)layer * 64 * 512 + col;
    const float* g2 = c.in[I_G2] + (size_t)layer * 128 * 512 + col;
    const float* v2 = c.in[I_V2] + (size_t)(layer > 0 ? layer - 1 : 0) * 32 * 512 + col;
    bf16_t* R = c.RW(); bf16_t* LD = c.RW() + (size_t)T * 512; bf16_t* KP = c.RW() + (size_t)2 * T * 512; bf16_t* VP = c.RW() + (size_t)3 * T * 512;
    bf16_t* KK = c.RW() + (size_t)4 * T * 512; bf16_t* BB = c.RW() + (size_t)5 * T * 512; bf16_t* GG = c.RW() + (size_t)6 * T * 512;
    for (int task = BID; task < T / 8; task += gridDim.x) {
        const int t0 = task * 8;
        __syncthreads();
        for (int e = tid; e < 288 * 8; e += NTHR) {
            const int tok = e / 288, k = e - tok * 288;
            const int t = t0 + tok, p = t % L;
            float v;
            if (k < 256) {
                const int zcol = Z_C + 1536 + k;
                const float cur = bf2f(c.Z()[(size_t)t * ZW + zcol]);
                const float prev = p > 0 ? bf2f(c.Z()[(size_t)(t - 1) * ZW + zcol]) : 0.f;
                v = cur + (prev - cur) * mu[1536 + k];
                if (k < 64) v = tanhf(v); else if (k >= 128) v = sigmoidf_(v);
            } else v = bf2f(c.Z()[(size_t)t * ZW + Z_VL + (k - 256)]);
            act[k * 8 + tok] = v;
        }
        __syncthreads();
        float aw[8], aa[8], ag[8], av[8];
#pragma unroll
        for (int i = 0; i < 8; ++i) { aw[i] = 0.f; aa[i] = 0.f; ag[i] = 0.f; av[i] = 0.f; }
        for (int k = 0; k < 64; ++k) {
            const float wv = w2[(size_t)k * 512], avv = a2[(size_t)k * 512];
#pragma unroll
            for (int q4 = 0; q4 < 2; ++q4) {
                const f32x4 x = *(const f32x4*)(act + k * 8 + q4 * 4), y = *(const f32x4*)(act + (64 + k) * 8 + q4 * 4);
#pragma unroll
                for (int j = 0; j < 4; ++j) { aw[q4 * 4 + j] += wv * x[j]; aa[q4 * 4 + j] += avv * y[j]; }
            }
        }
        for (int k = 0; k < 128; ++k) {
            const float gv = g2[(size_t)k * 512];
#pragma unroll
            for (int q4 = 0; q4 < 2; ++q4) {
                const f32x4 x = *(const f32x4*)(act + (128 + k) * 8 + q4 * 4);
#pragma unroll
                for (int j = 0; j < 4; ++j) ag[q4 * 4 + j] += gv * x[j];
            }
        }
        if (layer > 0) {
            for (int k = 0; k < 32; ++k) {
                const float vv = v2[(size_t)k * 512];
#pragma unroll
                for (int q4 = 0; q4 < 2; ++q4) {
                    const f32x4 x = *(const f32x4*)(act + (256 + k) * 8 + q4 * 4);
#pragma unroll
                    for (int j = 0; j < 4; ++j) av[q4 * 4 + j] += vv * x[j];
                }
            }
        }
#pragma unroll
        for (int tok = 0; tok < 8; ++tok) {
            const int t = t0 + tok, p = t % L;
            const bf16_t* zr = c.Z() + (size_t)t * ZW + Z_C + col;
            float rc = bf2f(zr[0]), kc = bf2f(zr[512]), vc = bf2f(zr[1024]);
            float rp = 0.f, kp = 0.f, vp = 0.f;
            if (p > 0) { rp = bf2f(zr[-ZW]); kp = bf2f(zr[512 - ZW]); vp = bf2f(zr[1024 - ZW]); }
            rc += (rp - rc) * mu_r; kc += (kp - kc) * mu_k; vc += (vp - vc) * mu_v;
            const float u = -(w0c + aw[tok]);
            const float spl = fmaxf(u, 0.f) + __logf(1.f + __expf(-fabsf(u)));
            const float wlog = -spl - 0.5f;
            const float ld = -__expf(wlog);
            const float a = sigmoidf_(a0c + aa[tok]);
            const float kkraw = kc * kkc;
            const float ss = wave_sum(kkraw * kkraw);
            const float kk = kkraw / fmaxf(sqrtf(ss), 1e-12f);
            const float kmod = kc * (1.f + (a - 1.f) * kac);
            const size_t o = (size_t)t * 512 + col;
            float vout = vc;
            if (layer == 0) c.VF()[o] = f2bf(vc);
            else { const float vf = bf2f(c.VF()[o]); vout = vc + (vf - vc) * sigmoidf_(v0c + av[tok]); }
            asm volatile("" ::: "memory");
            R[o] = f2bf(rc); LD[o] = f2bf(ld * LOG2E); KP[o] = f2bf(kmod); VP[o] = f2bf(vout); KK[o] = f2bf(kk); BB[o] = f2bf(kk * a); GG[o] = f2bf(ag[tok]);
        }
    }
}

constexpr int TC = 16, NCH = L / TC, STG = 7 * TC * 64;
struct RwOps { f32x4 w[2], k[2], kk[2], b[2], r[2]; f32x2 v; };
DEVINL void rw_load_ops(RwOps& o, const float* buf, int tt, int jo, int i0) {
    const float* p = buf + tt * 64 + jo * 8;
#pragma unroll
    for (int q = 0; q < 2; ++q) {
        o.r[q] = *(const f32x4*)(p + q * 4); o.w[q] = *(const f32x4*)(p + TC * 64 + q * 4); o.k[q] = *(const f32x4*)(p + 2 * TC * 64 + q * 4);
        o.kk[q] = *(const f32x4*)(p + 4 * TC * 64 + q * 4); o.b[q] = *(const f32x4*)(p + 5 * TC * 64 + q * 4);
    }
    o.v = *(const f32x2*)(buf + 3 * TC * 64 + tt * 64 + i0);
}
DEVINL float oct_sum(float v) { v += DPPF(v, 0xB1); v += DPPF(v, 0x4E); v += DPPF(v, 0x141); return v; }
DEVINL f32x2 rw_step(f32x2 (&S0)[4], f32x2 (&S1)[4], const RwOps& o) {
    f32x2 a0 = {0.f, 0.f}, a1 = {0.f, 0.f};
#pragma unroll
    for (int p = 0; p < 4; ++p) { const f32x2 kk2 = {o.kk[p >> 1][(p & 1) * 2], o.kk[p >> 1][(p & 1) * 2 + 1]}; a0 += S0[p] * kk2; a1 += S1[p] * kk2; }
    const float sa0 = oct_sum(a0[0] + a0[1]), sa1 = oct_sum(a1[0] + a1[1]);
    const f32x2 n0 = {-sa0, -sa0}, n1 = {-sa1, -sa1}, v0 = {o.v[0], o.v[0]}, v1 = {o.v[1], o.v[1]};
    f32x2 y0 = {0.f, 0.f}, y1 = {0.f, 0.f};
#pragma unroll
    for (int p = 0; p < 4; ++p) {
        const int q = p >> 1, e = (p & 1) * 2;
        const f32x2 k2 = {o.k[q][e], o.k[q][e + 1]}, b2 = {o.b[q][e], o.b[q][e + 1]}, w2 = {o.w[q][e], o.w[q][e + 1]}, r2 = {o.r[q][e], o.r[q][e + 1]};
        S0[p] = S0[p] * w2 + (v0 * k2 + n0 * b2);
        S1[p] = S1[p] * w2 + (v1 * k2 + n1 * b2);
        y0 += S0[p] * r2; y1 += S1[p] * r2;
    }
    f32x2 y = {oct_sum(y0[0] + y0[1]), oct_sum(y1[0] + y1[1])};
    return y;
}
DEVINL void rw_stage(const bf16_t* rwbase, int t0, int hd, float* buf, int ht, int nth) {
    for (int item = ht; item < 7 * TC * 8; item += nth) {
        const int arr = item / (TC * 8), rem = item - arr * (TC * 8), tt = rem >> 3, c8 = rem & 7;
        const u32x4 raw = *(const u32x4*)(rwbase + (size_t)arr * T * 512 + (size_t)(t0 + tt) * 512 + hd * 64 + c8 * 8);
        f32x4 lo = {bflo(raw[0]), bfhi(raw[0]), bflo(raw[1]), bfhi(raw[1])}, hi = {bflo(raw[2]), bfhi(raw[2]), bflo(raw[3]), bfhi(raw[3])};
        if (arr == 1) {
#pragma unroll
            for (int j = 0; j < 4; ++j) { lo[j] = fexp2(lo[j]); hi[j] = fexp2(hi[j]); }
        }
        float* d = buf + arr * TC * 64 + tt * 64 + c8 * 8;
        *(f32x4*)d = lo; *(f32x4*)(d + 4) = hi;
    }
}
DEVINL void rw_stage_load(u32x4 (&raw)[4], const bf16_t* rwbase, int t0, int hd, int ht) {
    const int rem = ht & 127, tt = rem >> 3, c8 = rem & 7;
#pragma unroll
    for (int k = 0; k < 4; ++k) {
        const int arr = (ht >> 7) + 2 * k;
        if (arr < 7) raw[k] = *(const u32x4*)(rwbase + (size_t)arr * T * 512 + (size_t)(t0 + tt) * 512 + hd * 64 + c8 * 8);
    }
}
DEVINL void rw_stage_write(const u32x4 (&raw)[4], float* buf, int ht) {
    const int rem = ht & 127, tt = rem >> 3, c8 = rem & 7;
#pragma unroll
    for (int k = 0; k < 4; ++k) {
        const int arr = (ht >> 7) + 2 * k;
        if (arr < 7) {
            f32x4 lo = {bflo(raw[k][0]), bfhi(raw[k][0]), bflo(raw[k][1]), bfhi(raw[k][1])}, hi = {bflo(raw[k][2]), bfhi(raw[k][2]), bflo(raw[k][3]), bfhi(raw[k][3])};
            if (arr == 1) {
#pragma unroll
                for (int j = 0; j < 4; ++j) { lo[j] = fexp2(lo[j]); hi[j] = fexp2(hi[j]); }
            }
            float* d = buf + arr * TC * 64 + tt * 64 + c8 * 8;
            *(f32x4*)d = lo; *(f32x4*)(d + 4) = hi;
        }
    }
}
DEVINL void rw_wait_ready(const unsigned* cnt3, unsigned need, int nP) {
    for (int j = 0; j < nP; ++j)
        while (__hip_atomic_load(cnt3 + j, __ATOMIC_RELAXED, __HIP_MEMORY_SCOPE_AGENT) < need) __builtin_amdgcn_s_sleep(8);
    __builtin_amdgcn_fence(__ATOMIC_ACQUIRE, "agent");
    asm volatile("s_waitcnt vmcnt(0)" ::: "memory");
}
DEVINL void rwkv_scan(const Ctx& c, int layer, int b, int hd, const unsigned* cnt3, int nP, float* lds) {
    float* sy = lds + 3 * STG;
    const int tid = TID, lane = tid & 63, w = tid >> 6;
    const bf16_t* rwbase = c.RW();
    const bf16_t* GG = c.RW() + (size_t)6 * T * 512;
    bf16_t* Y = c.Y() + (size_t)2 * T * 512;
    const int rp = lane >> 3, jo = lane & 7, i0 = 16 * (w & 3) + 2 * rp;
    f32x2 S0[4], S1[4];
#pragma unroll
    for (int j = 0; j < 4; ++j) { S0[j] = (f32x2){0.f, 0.f}; S1[j] = (f32x2){0.f, 0.f}; }
    const float lng = c.in[I_LNG][layer * 512 + hd * 64 + lane], lnb = c.in[I_LNB][layer * 512 + hd * 64 + lane], rkv = c.in[I_RK][layer * 512 + hd * 64 + lane];
    __syncthreads();
    unsigned have = (unsigned)(layer * 16 + 1);
    rw_wait_ready(cnt3, have, nP);
    rw_stage(rwbase, b * L, hd, lds, tid, NTHR);
    u32x4 raw[4];
#pragma unroll
    for (int k = 0; k < 4; ++k) raw[k] = (u32x4){0u, 0u, 0u, 0u};
    if (w >= 4) rw_stage_load(raw, rwbase, b * L + TC, hd, tid - 256);
    __syncthreads();
    for (int ch = 0; ch <= NCH; ++ch) {
        if (w < 4) {
            if (ch < NCH) {
                const float* buf = lds + (ch % 3) * STG;
                float* syw = sy + (ch & 1) * TC * 64;
                RwOps ops[3];
                rw_load_ops(ops[0], buf, 0, jo, i0);
                rw_load_ops(ops[1], buf, 1, jo, i0);
#pragma unroll
                for (int tt = 0; tt < TC; ++tt) {
                    if (tt + 2 < TC) rw_load_ops(ops[(tt + 2) % 3], buf, tt + 2, jo, i0);
                    const f32x2 y = rw_step(S0, S1, ops[tt % 3]);
                    *(f32x2*)(syw + tt * 64 + i0) = y;
                }
            }
        } else {
            const int ht = tid - 256, hw = w - 4;
            if (ch + 1 < NCH) rw_stage_write(raw, lds + ((ch + 1) % 3) * STG, ht);
            if (ch + 2 < NCH) {
                const unsigned need = (unsigned)(layer * 16 + (ch + 2) / (7 * nP) + 1);
                if (need > have) { rw_wait_ready(cnt3, need, nP); have = need; }
                rw_stage_load(raw, rwbase, b * L + (ch + 2) * TC, hd, ht);
            }
            if (ch >= 1) {
                const int pc = ch - 1, t0 = b * L + pc * TC;
                const float* buf = lds + (pc % 3) * STG;
                const float* syr = sy + (pc & 1) * TC * 64;
#pragma unroll
                for (int k4 = 0; k4 < TC / 4; ++k4) {
                    const int tt = hw + 4 * k4, e = tt * 64 + lane;
                    const float y = syr[e];
                    const size_t idx = (size_t)(t0 + tt) * 512 + hd * 64 + lane;
                    const float gate = buf[6 * TC * 64 + e];
                    const float s1 = wave_sum_dpp(y), s2 = wave_sum_dpp(y * y), s3 = wave_sum_dpp(buf[e] * buf[2 * TC * 64 + e] * rkv);
                    const float mean = s1 * (1.f / 64.f);
                    const float var = fmaxf(s2 * (1.f / 64.f) - mean * mean, 0.f);
                    const float yn = (y - mean) * rsqrtf(var + 64e-5f) * lng + lnb;
                    Y[idx] = f2bf((yn + s3 * buf[3 * TC * 64 + e]) * gate);
                }
            }
        }
        __syncthreads();
    }
}


typedef float f32x4v __attribute__((ext_vector_type(4)));
#define MFMA16(a, b, c) __builtin_amdgcn_mfma_f32_16x16x32_bf16((a), (b), (c), 0, 0, 0)
constexpr int RP_KP = 296, RP_BW_BYTES = 64 * RP_KP * 2, RP_WAVE_BYTES = 16 * RP_KP * 2 + 16 * 192 * 2, RP_NW = 7, RP_NG = L / 16;
DEVINL float row16_sum(float v) { v += DPPF(v, 0xB1); v += DPPF(v, 0x4E); v += DPPF(v, 0x141); v += DPPF(v, 0x140); return v; }
DEVINL void rw_project_head(const Ctx& c, int layer, int b, int hd, int pj, int nP, unsigned* cnt, unsigned char* lds) {
    const int tid = TID, lane = tid & 63, w = tid >> 6, cl = lane & 15, kg = lane >> 4;
    bf16_t* BW = (bf16_t*)lds;
    bf16_t* ACT = (bf16_t*)(lds + RP_BW_BYTES + (w < RP_NW ? w : 0) * RP_WAVE_BYTES);
    bf16_t* RKV = ACT + 16 * RP_KP;
    const float* mu = c.in[I_MU] + layer * 1792;
    __syncthreads();
    {
        const float* w2 = c.in[I_W2] + (size_t)layer * 64 * 512 + hd * 64;
        const float* a2 = c.in[I_A2] + (size_t)layer * 64 * 512 + hd * 64;
        const float* g2 = c.in[I_G2] + (size_t)layer * 128 * 512 + hd * 64;
        const float* v2 = c.in[I_V2] + (size_t)(layer > 0 ? layer - 1 : 0) * 32 * 512 + hd * 64;
        for (int e = tid; e < 64 * 288; e += NTHR) {
            const int k = e >> 6, col = e & 63;
            float v;
            if (k < 64) v = w2[(size_t)k * 512 + col];
            else if (k < 128) v = a2[(size_t)(k - 64) * 512 + col];
            else if (k < 256) v = g2[(size_t)(k - 128) * 512 + col];
            else v = layer > 0 ? v2[(size_t)(k - 256) * 512 + col] : 0.f;
            BW[col * RP_KP + k] = f2bf(v);
        }
    }
    float w0c[4], a0c[4], kkc[4], kac[4], v0c[4];
#pragma unroll
    for (int nt = 0; nt < 4; ++nt) {
        const int col = layer * 512 + hd * 64 + nt * 16 + cl;
        w0c[nt] = c.in[I_W0][col]; a0c[nt] = c.in[I_A0][col]; kkc[nt] = c.in[I_KKW][col]; kac[nt] = c.in[I_KAW][col];
        v0c[nt] = layer > 0 ? c.in[I_V0][(layer - 1) * 512 + hd * 64 + nt * 16 + cl] : 0.f;
    }
    bf16_t* R = c.RW(); bf16_t* LD = c.RW() + (size_t)T * 512; bf16_t* KP = c.RW() + (size_t)2 * T * 512; bf16_t* VP = c.RW() + (size_t)3 * T * 512;
    bf16_t* KK = c.RW() + (size_t)4 * T * 512; bf16_t* BB = c.RW() + (size_t)5 * T * 512; bf16_t* GG = c.RW() + (size_t)6 * T * 512;
    const bf16_t* Zb = c.Z();
    int round = 0;
    for (int q0 = 0; nP * q0 + pj < RP_NG; q0 += RP_NW, ++round) {
        const int g = nP * (q0 + w) + pj;
        const bool act = (w < RP_NW) && (g < RP_NG);
        const int t0 = b * L + g * 16;
        __syncthreads();
        if (act) {
            {
                const int ch = lane & 31, par = lane >> 5, k = ch * 8;
                const f32x4 m0 = *(const f32x4*)(mu + 1536 + k), m1 = *(const f32x4*)(mu + 1536 + k + 4);
                const float fa = (ch < 8) ? 1.f : 0.f, fb = (ch < 8) ? -2.f : 1.f, fs = (ch < 8) ? 2.f * LOG2E : -LOG2E;
                const bool ident = (ch >= 8 && ch < 16);
                u32x4 cu[8], pr[8];
#pragma unroll
                for (int i = 0; i < 8; ++i) {
                    const int t = t0 + 2 * i + par;
                    cu[i] = *(const u32x4*)(Zb + (size_t)t * ZW + Z_C + 1536 + k);
                    pr[i] = (u32x4){0u, 0u, 0u, 0u};
                    if (t - b * L > 0) pr[i] = *(const u32x4*)(Zb + (size_t)(t - 1) * ZW + Z_C + 1536 + k);
                }
#pragma unroll
                for (int i = 0; i < 8; ++i) {
                    u32x4 o;
#pragma unroll
                    for (int j = 0; j < 4; ++j) {
                        const float c0 = bflo(cu[i][j]), c1 = bfhi(cu[i][j]), p0 = bflo(pr[i][j]), p1 = bfhi(pr[i][j]);
                        const float ma = (j < 2) ? m0[2 * j] : m1[2 * j - 4], mb = (j < 2) ? m0[2 * j + 1] : m1[2 * j - 3];
                        const float x0 = c0 + (p0 - c0) * ma, x1 = c1 + (p1 - c1) * mb;
                        const float y0 = fa + fb * __builtin_amdgcn_rcpf(1.f + fexp2(x0 * fs)), y1 = fa + fb * __builtin_amdgcn_rcpf(1.f + fexp2(x1 * fs));
                        o[j] = cvt_pk_bf16(ident ? x0 : y0, ident ? x1 : y1);
                    }
                    *(u32x4*)(ACT + (2 * i + par) * RP_KP + k) = o;
                }
                const int tokv = lane >> 2, kv = (lane & 3) * 8;
                *(u32x4*)(ACT + tokv * RP_KP + 256 + kv) = *(const u32x4*)(Zb + (size_t)(t0 + tokv) * ZW + Z_VL + kv);
            }
            {
                u32x4 cu[6], pr[6];
#pragma unroll
                for (int i = 0; i < 6; ++i) {
                    const int it = lane + 64 * i, tok = it / 24, rem = it - tok * 24, arr = rem >> 3, c8 = (rem & 7) * 8;
                    const int t = t0 + tok;
                    const int zcol = Z_C + arr * 512 + hd * 64 + c8;
                    cu[i] = *(const u32x4*)(Zb + (size_t)t * ZW + zcol);
                    pr[i] = (u32x4){0u, 0u, 0u, 0u};
                    if (t - b * L > 0) pr[i] = *(const u32x4*)(Zb + (size_t)(t - 1) * ZW + zcol);
                }
#pragma unroll
                for (int i = 0; i < 6; ++i) {
                    const int it = lane + 64 * i, tok = it / 24, rem = it - tok * 24, arr = rem >> 3, c8 = (rem & 7) * 8;
                    const f32x4 m0 = *(const f32x4*)(mu + arr * 512 + hd * 64 + c8), m1 = *(const f32x4*)(mu + arr * 512 + hd * 64 + c8 + 4);
                    u32x4 o;
#pragma unroll
                    for (int j = 0; j < 4; ++j) {
                        const float c0 = bflo(cu[i][j]), c1 = bfhi(cu[i][j]), p0 = bflo(pr[i][j]), p1 = bfhi(pr[i][j]);
                        const float ma = (j < 2) ? m0[2 * j] : m1[2 * j - 4], mb = (j < 2) ? m0[2 * j + 1] : m1[2 * j - 3];
                        o[j] = cvt_pk_bf16(c0 + (p0 - c0) * ma, c1 + (p1 - c1) * mb);
                    }
                    *(u32x4*)(RKV + tok * 192 + arr * 64 + c8) = o;
                }
            }
        }
        __syncthreads();
        if (act) {
            bf16x8 af[9];
#pragma unroll
            for (int ks = 0; ks < 9; ++ks) af[ks] = *(const bf16x8*)(ACT + cl * RP_KP + ks * 32 + kg * 8);
            float kkraw[4][4], av[4][4], ldv[4][4], gv[4][4], kmod[4][4], vout[4][4], rcv[4][4];
            float ss[4] = {0.f, 0.f, 0.f, 0.f};
#pragma unroll
            for (int nt = 0; nt < 4; ++nt) {
                const bf16_t* bp = BW + (nt * 16 + cl) * RP_KP + kg * 8;
                f32x4v aw = {0.f, 0.f, 0.f, 0.f}, aa = aw, ag = aw, avv = aw;
                aw = MFMA16(af[0], *(const bf16x8*)(bp), aw); aw = MFMA16(af[1], *(const bf16x8*)(bp + 32), aw);
                aa = MFMA16(af[2], *(const bf16x8*)(bp + 64), aa); aa = MFMA16(af[3], *(const bf16x8*)(bp + 96), aa);
#pragma unroll
                for (int ks = 4; ks < 8; ++ks) ag = MFMA16(af[ks], *(const bf16x8*)(bp + ks * 32), ag);
                avv = MFMA16(af[8], *(const bf16x8*)(bp + 256), avv);
#pragma unroll
                for (int rg = 0; rg < 4; ++rg) {
                    const int tk = kg * 4 + rg;
                    const bf16_t* rk = RKV + tk * 192 + nt * 16 + cl;
                    const float rc = bf2f(rk[0]), kc = bf2f(rk[64]), vc = bf2f(rk[128]);
                    const float u = -(w0c[nt] + aw[rg]);
                    const float spl = fmaxf(u, 0.f) + flog2(1.f + fexp2(-fabsf(u) * LOG2E)) * (1.f / LOG2E);
                    ldv[nt][rg] = -fexp2((-spl - 0.5f) * LOG2E) * LOG2E;
                    const float a = sigmoidf_(a0c[nt] + aa[rg]);
                    av[nt][rg] = a; gv[nt][rg] = ag[rg]; rcv[nt][rg] = rc;
                    const float kr = kc * kkc[nt];
                    kkraw[nt][rg] = kr; ss[rg] += kr * kr;
                    kmod[nt][rg] = kc * (1.f + (a - 1.f) * kac[nt]);
                    const size_t o = (size_t)(t0 + tk) * 512 + hd * 64 + nt * 16 + cl;
                    float vo = vc;
                    if (layer == 0) c.VF()[o] = f2bf(vc);
                    else { const float vf = bf2f(c.VF()[o]); vo = vc + (vf - vc) * sigmoidf_(v0c[nt] + avv[rg]); }
                    vout[nt][rg] = vo;
                }
            }
            float inv[4];
#pragma unroll
            for (int rg = 0; rg < 4; ++rg) inv[rg] = fminf(__builtin_amdgcn_rsqf(row16_sum(ss[rg])), 1e12f);
#pragma unroll
            for (int nt = 0; nt < 4; ++nt)
#pragma unroll
                for (int rg = 0; rg < 4; ++rg) {
                    const size_t o = (size_t)(t0 + kg * 4 + rg) * 512 + hd * 64 + nt * 16 + cl;
                    const float kk = kkraw[nt][rg] * inv[rg];
                    R[o] = f2bf(rcv[nt][rg]); LD[o] = f2bf(ldv[nt][rg]); KP[o] = f2bf(kmod[nt][rg]); VP[o] = f2bf(vout[nt][rg]);
                    KK[o] = f2bf(kk); BB[o] = f2bf(kk * av[nt][rg]); GG[o] = f2bf(gv[nt][rg]);
                }
        }
        asm volatile("s_waitcnt vmcnt(0)" ::: "memory");
        __syncthreads();
        if (threadIdx.x == 0) {
            __builtin_amdgcn_fence(__ATOMIC_RELEASE, "agent");
            __hip_atomic_store(cnt, (unsigned)(layer * 16 + round + 1), __ATOMIC_RELAXED, __HIP_MEMORY_SCOPE_AGENT);
        }
    }
    __syncthreads();
}

DEVINL void ret_block(const Ctx& c, int b, int hd, unsigned char* lds) {
    bf16_t* ST = (bf16_t*)lds;
    float* ssq = (float*)(lds + 128 * LROW);
    const int tid = TID, lane = tid & 63, w = tid >> 6, r = lane & 31, h = lane >> 5;
    const int qs = w & 3, dh = w >> 2, dvt = w >> 1, dt = w & 1;
    const float lg2 = flog2(1.f - fexp2(-5.f - (float)hd));
    const float gam = fexp2(lg2), gam128 = fexp2(lg2 * 128.f);
    f32x16 sacc;
#pragma unroll
    for (int i = 0; i < 16; ++i) sacc[i] = 0.f;
    const bf16_t* vtb = c.BVT() + (size_t)(b * 512 + hd * 128) * L;
    const bf16_t* ktb = c.BKT() + (size_t)(b * 256 + hd * 64) * L;
    bf16_t* Y = c.Y() + (size_t)T * 512;
    for (int ch = 0; ch < L / 128; ++ch) {
        const int t0 = b * L + ch * 128, p0 = ch * 128;
        __syncthreads();
#pragma unroll
        for (int i = 0; i < 16; ++i) {
            const int dv = dvt * 32 + (i & 3) + 8 * (i >> 2) + 4 * h;
            ST[dv * 72 + dt * 32 + r] = f2bf(sacc[i]);
        }
        __syncthreads();
        const int ql = qs * 32 + r;
        bf16x8 qf[4];
        const bf16_t* qp = c.Z() + (size_t)(t0 + ql) * ZW + Z_BQ + hd * 64 + 8 * h;
#pragma unroll
        for (int s = 0; s < 4; ++s) qf[s] = *(const bf16x8*)(qp + 16 * s);
        f32x16 o[2];
#pragma unroll
        for (int d = 0; d < 2; ++d) {
#pragma unroll
            for (int i = 0; i < 16; ++i) o[d][i] = 0.f;
#pragma unroll
            for (int s = 0; s < 4; ++s) {
                const bf16x8 sf = *(const bf16x8*)(ST + (dh * 64 + d * 32 + r) * 72 + 16 * s + 8 * h);
                o[d] = MFMA32(sf, qf[s], o[d]);
            }
#pragma unroll
            for (int i = 0; i < 16; ++i) o[d][i] *= gam;
        }
        for (int kt = 0; kt <= qs; ++kt) {
            const bf16_t* kp = c.Z() + (size_t)(t0 + kt * 32 + r) * ZW + Z_BK + hd * 64 + 8 * h;
            f32x16 st;
#pragma unroll
            for (int i = 0; i < 16; ++i) st[i] = 0.f;
#pragma unroll
            for (int s = 0; s < 4; ++s) { const bf16x8 kf = *(const bf16x8*)(kp + 16 * s); st = MFMA32(kf, qf[s], st); }
            bf16x8 pf[2];
#pragma unroll
            for (int s = 0; s < 2; ++s) {
                u32x4 pk;
#pragma unroll
                for (int jj = 0; jj < 4; ++jj) {
                    float a2[2];
#pragma unroll
                    for (int e = 0; e < 2; ++e) {
                        const int i = 8 * s + 2 * jj + e;
                        const int kl = kt * 32 + (i & 3) + 8 * (i >> 2) + 4 * h;
                        a2[e] = (kl <= ql) ? st[i] * fexp2(-lg2 * (float)kl) : 0.f;
                    }
                    pk[jj] = cvt_pk_bf16(a2[0], a2[1]);
                }
                pf[s] = __builtin_bit_cast(bf16x8, pk);
            }
#pragma unroll
            for (int d = 0; d < 2; ++d) {
                const bf16_t* vp = vtb + (size_t)(dh * 64 + d * 32 + r) * L + p0 + kt * 32 + 4 * h;
#pragma unroll
                for (int s = 0; s < 2; ++s) {
                    const u32x2 lo = *(const u32x2*)(vp + 16 * s), hi = *(const u32x2*)(vp + 16 * s + 8);
                    u32x4 vv = {lo[0], lo[1], hi[0], hi[1]};
                    o[d] = MFMA32(__builtin_bit_cast(bf16x8, vv), pf[s], o[d]);
                }
            }
        }
        const float gq = fexp2(lg2 * (float)ql);
        float ss = 0.f;
#pragma unroll
        for (int d = 0; d < 2; ++d)
#pragma unroll
            for (int i = 0; i < 16; ++i) { o[d][i] *= gq; ss += o[d][i] * o[d][i]; }
        ss += __shfl_xor(ss, 32);
        if (h == 0) ssq[dh * 128 + ql] = ss;
        __syncthreads();
        const float rs = rsqrtf((ssq[ql] + ssq[128 + ql]) * (1.f / 128.f) + 1e-6f);
        {
            const bf16_t* gp = c.Z() + (size_t)(t0 + ql) * ZW + Z_BG + hd * 128 + dh * 64;
            bf16_t* yp = Y + (size_t)(t0 + ql) * 512 + hd * 128 + dh * 64;
#pragma unroll
            for (int d = 0; d < 2; ++d)
#pragma unroll
                for (int g = 0; g < 4; ++g) {
                    const int dl = d * 32 + 8 * g + 4 * h;
                    const u32x2 gg = *(const u32x2*)(gp + dl);
                    float gv[4] = {bflo(gg[0]), bfhi(gg[0]), bflo(gg[1]), bfhi(gg[1])};
                    float ov[4];
#pragma unroll
                    for (int j = 0; j < 4; ++j) { const float sg = gv[j] * sigmoidf_(gv[j]); ov[j] = sg * o[d][4 * g + j] * rs; }
                    u32x2 pk; pk[0] = cvt_pk_bf16(ov[0], ov[1]); pk[1] = cvt_pk_bf16(ov[2], ov[3]);
                    *(u32x2*)(yp + dl) = pk;
                }
        }
#pragma unroll
        for (int i = 0; i < 16; ++i) sacc[i] *= gam128;
        {
            const bf16_t* va = vtb + (size_t)(dvt * 32 + r) * L + p0 + 8 * h;
            const bf16_t* kb = ktb + (size_t)(dt * 32 + r) * L + p0 + 8 * h;
#pragma unroll 2
            for (int ks = 0; ks < 8; ++ks) {
                const bf16x8 vf = *(const bf16x8*)(va + 16 * ks);
                const u32x4 kr = *(const u32x4*)(kb + 16 * ks);
                u32x4 kd;
#pragma unroll
                for (int jj = 0; jj < 4; ++jj) {
                    const int j0 = 16 * ks + 8 * h + 2 * jj;
                    kd[jj] = cvt_pk_bf16(bflo(kr[jj]) * fexp2(lg2 * (float)(127 - j0)), bfhi(kr[jj]) * fexp2(lg2 * (float)(126 - j0)));
                }
                sacc = MFMA32(vf, __builtin_bit_cast(bf16x8, kd), sacc);
            }
        }
    }
}

DEVINL void sb_task(const Ctx& c, int b, int hd, int qg) {
    const int lane = TID & 63, r = lane & 31, h = lane >> 5;
    const int q0 = qg * 32;
    bf16_t* yp = c.Y() + (size_t)(b * L + q0 + r) * 512 + hd * 64;
    if (qg < 3) {
        u32x2 z = {0u, 0u};
#pragma unroll
        for (int d = 0; d < 2; ++d)
#pragma unroll
            for (int g = 0; g < 4; ++g) *(u32x2*)(yp + d * 32 + 8 * g + 4 * h) = z;
        return;
    }
    const bf16_t* zb = c.Z() + (size_t)b * L * ZW;
    bf16x8 qf[4];
    {
        const bf16_t* qp = zb + (size_t)(q0 + r) * ZW + Z_AQ + hd * 64 + 8 * h;
#pragma unroll
        for (int s = 0; s < 4; ++s) qf[s] = *(const bf16x8*)(qp + 16 * s);
    }
    f32x16 o[2];
#pragma unroll
    for (int d = 0; d < 2; ++d)
#pragma unroll
        for (int i = 0; i < 16; ++i) o[d][i] = 0.f;
    float carry = 0.f;
    const int qpos = q0 + r;
    const bf16_t* vtb = c.AVT() + (size_t)(b * 512 + hd * 64 + r) * L + 4 * h;
    bf16x8 kfn[4], vfn[2][2], kfm[4], vfm[2][2];
#define SB_LOAD(KF, VF, KT) do { const int k0_ = (KT) * 32; const bf16_t* kp_ = zb + (size_t)(k0_ + r) * ZW + Z_AK + hd * 64 + 8 * h; \
        _Pragma("unroll") for (int s_ = 0; s_ < 4; ++s_) KF[s_] = *(const bf16x8*)(kp_ + 16 * s_); \
        _Pragma("unroll") for (int d_ = 0; d_ < 2; ++d_) _Pragma("unroll") for (int s_ = 0; s_ < 2; ++s_) { \
            const bf16_t* vp_ = vtb + (size_t)(d_ * 32) * L + k0_ + 16 * s_; const u32x2 lo_ = *(const u32x2*)(vp_), hi_ = *(const u32x2*)(vp_ + 8); \
            u32x4 vv_ = {lo_[0], lo_[1], hi_[0], hi_[1]}; VF[d_][s_] = __builtin_bit_cast(bf16x8, vv_); } } while (0)
    SB_LOAD(kfn, vfn, qg);
    SB_LOAD(kfm, vfm, (qg > 3 ? qg - 1 : 3));
    for (int kt = qg; kt >= 3; --kt) {
        const int k0 = kt * 32;
        bf16x8 kf[4], vf[2][2];
#pragma unroll
        for (int s = 0; s < 4; ++s) { kf[s] = kfn[s]; kfn[s] = kfm[s]; }
#pragma unroll
        for (int d = 0; d < 2; ++d)
#pragma unroll
            for (int s = 0; s < 2; ++s) { vf[d][s] = vfn[d][s]; vfn[d][s] = vfm[d][s]; }
        SB_LOAD(kfm, vfm, (kt > 4 ? kt - 2 : 3));
        f32x16 st;
#pragma unroll
        for (int i = 0; i < 16; ++i) st[i] = 0.f;
#pragma unroll
        for (int s = 0; s < 4; ++s) st = MFMA32(kf[s], qf[s], st);
        const bool boundary = (kt == qg) || (kt == 3);
        float x[16], ls[16];
#pragma unroll
        for (int i = 0; i < 16; ++i) {
            const float z = st[i];
            const float sp = fmaxf(z, 0.f) + flog2(1.f + fexp2(-fabsf(z)));
            const int key = k0 + (i & 3) + 8 * (i >> 2) + 4 * h;
            const bool ok = !boundary || (key < qpos && key >= 112);
            x[i] = ok ? -sp : 0.f;
            ls[i] = ok ? z - sp : -INFINITY;
        }
        float og[4], tot[4];
#pragma unroll
        for (int g = 0; g < 4; ++g) {
            const float gs = (x[4 * g] + x[4 * g + 1]) + (x[4 * g + 2] + x[4 * g + 3]);
            og[g] = __shfl_xor(gs, 32);
            tot[g] = gs + og[g];
        }
        float suf[4];
        suf[3] = 0.f; suf[2] = tot[3]; suf[1] = suf[2] + tot[2]; suf[0] = suf[1] + tot[1];
        float a[16];
#pragma unroll
        for (int g = 0; g < 4; ++g) {
            float af = carry + suf[g] + (h == 0 ? og[g] : 0.f);
            a[4 * g + 3] = fexp2(ls[4 * g + 3] + af); af += x[4 * g + 3];
            a[4 * g + 2] = fexp2(ls[4 * g + 2] + af); af += x[4 * g + 2];
            a[4 * g + 1] = fexp2(ls[4 * g + 1] + af); af += x[4 * g + 1];
            a[4 * g + 0] = fexp2(ls[4 * g + 0] + af);
        }
        carry += (tot[0] + tot[1]) + (tot[2] + tot[3]);
        const bool sb_done = __all(carry < -80.f);
#pragma unroll
        for (int s = 0; s < 2; ++s) {
            u32x4 pk;
#pragma unroll
            for (int jj = 0; jj < 4; ++jj) pk[jj] = cvt_pk_bf16(a[8 * s + 2 * jj], a[8 * s + 2 * jj + 1]);
            const bf16x8 pf = __builtin_bit_cast(bf16x8, pk);
            o[0] = MFMA32(vf[0][s], pf, o[0]);
            o[1] = MFMA32(vf[1][s], pf, o[1]);
        }
        if (sb_done) break;
    }
#pragma unroll
    for (int d = 0; d < 2; ++d)
#pragma unroll
        for (int g = 0; g < 4; ++g) {
            u32x2 pk; pk[0] = cvt_pk_bf16(o[d][4 * g], o[d][4 * g + 1]); pk[1] = cvt_pk_bf16(o[d][4 * g + 2], o[d][4 * g + 3]);
            *(u32x2*)(yp + d * 32 + 8 * g + 4 * h) = pk;
        }
}

DEVINL void swa_task(const Ctx& c, int layer, int b, int qh, int qg) {
    const int lane = TID & 63, r = lane & 31, h = lane >> 5;
    const int q0 = qg * 32, kvh = qh >> 2;
    bf16_t* yp = c.Y() + (size_t)3 * T * 512 + (size_t)(b * L + q0 + r) * 512 + qh * 64;
    if (qg < 3) {
        u32x2 z = {0u, 0u};
#pragma unroll
        for (int d = 0; d < 2; ++d)
#pragma unroll
            for (int g = 0; g < 4; ++g) *(u32x2*)(yp + d * 32 + 8 * g + 4 * h) = z;
        return;
    }
    const bf16_t* zb = c.Z() + (size_t)b * L * ZW;
    bf16x8 qf[4];
    {
        const bf16_t* qp = zb + (size_t)(q0 + r) * ZW + Z_DQ + qh * 64 + 8 * h;
#pragma unroll
        for (int s = 0; s < 4; ++s) qf[s] = *(const bf16x8*)(qp + 16 * s);
    }
    f32x16 o[2];
#pragma unroll
    for (int d = 0; d < 2; ++d)
#pragma unroll
        for (int i = 0; i < 16; ++i) o[d][i] = 0.f;
    const float slope2 = fexp2(-(float)(qh + 1)) * LOG2E;
    float mrun = c.in[I_SINK][layer * 8 + qh] * LOG2E, lrun = 1.f;
    const int qpos = q0 + r;
    const bf16_t* vtb = c.DVT() + (size_t)(b * 128 + kvh * 64 + r) * L + 4 * h;
    const int kt_lo = (qg - 4) > 4 ? (qg - 4) : 4;
    const int ntiles = 1 + (qg >= 4 ? (qg - kt_lo + 1) : 0);
    bf16x8 kfn[4], vfn[2][2];
#define SWA_LOAD(KT) do { const int k0_ = (KT) * 32; const bf16_t* kp_ = zb + (size_t)(k0_ + r) * ZW + Z_DK + kvh * 64 + 8 * h; \
        _Pragma("unroll") for (int s_ = 0; s_ < 4; ++s_) kfn[s_] = *(const bf16x8*)(kp_ + 16 * s_); \
        _Pragma("unroll") for (int d_ = 0; d_ < 2; ++d_) _Pragma("unroll") for (int s_ = 0; s_ < 2; ++s_) { \
            const bf16_t* vp_ = vtb + (size_t)(d_ * 32) * L + k0_ + 16 * s_; const u32x2 lo_ = *(const u32x2*)(vp_), hi_ = *(const u32x2*)(vp_ + 8); \
            u32x4 vv_ = {lo_[0], lo_[1], hi_[0], hi_[1]}; vfn[d_][s_] = __builtin_bit_cast(bf16x8, vv_); } } while (0)
    SWA_LOAD(3);
    for (int it = 0; it < ntiles; ++it) {
        const bool meta = (it == 0);
        const int kt = meta ? 3 : (kt_lo + it - 1);
        const int k0 = kt * 32;
        bf16x8 kf[4], vf[2][2];
#pragma unroll
        for (int s = 0; s < 4; ++s) kf[s] = kfn[s];
#pragma unroll
        for (int d = 0; d < 2; ++d)
#pragma unroll
            for (int s = 0; s < 2; ++s) vf[d][s] = vfn[d][s];
        { const int nk = (it + 1 < ntiles) ? (kt_lo + it) : kt; SWA_LOAD(nk); }
        f32x16 st;
#pragma unroll
        for (int i = 0; i < 16; ++i) st[i] = 0.f;
#pragma unroll
        for (int s = 0; s < 4; ++s) st = MFMA32(kf[s], qf[s], st);
        float sc[16]; float tmax = -INFINITY;
#pragma unroll
        for (int i = 0; i < 16; ++i) {
            const int key = k0 + (i & 3) + 8 * (i >> 2) + 4 * h;
            const int dist = qpos - key;
            const bool ok = meta ? (key >= 112 && dist >= 0) : (dist >= 0 && dist < 128);
            const float v = meta ? st[i] : st[i] - slope2 * (float)dist;
            sc[i] = ok ? v : -INFINITY;
            tmax = fmaxf(tmax, sc[i]);
        }
        tmax = fmaxf(tmax, __shfl_xor(tmax, 32));
        const float mnew = fmaxf(mrun, tmax);
        const float alpha = fexp2(mrun - mnew);
        float psum = 0.f; float pv[16];
#pragma unroll
        for (int i = 0; i < 16; ++i) { pv[i] = fexp2(sc[i] - mnew); psum += pv[i]; }
        psum += __shfl_xor(psum, 32);
        lrun = lrun * alpha + psum; mrun = mnew;
#pragma unroll
        for (int d = 0; d < 2; ++d)
#pragma unroll
            for (int i = 0; i < 16; ++i) o[d][i] *= alpha;
#pragma unroll
        for (int s = 0; s < 2; ++s) {
            u32x4 pk;
#pragma unroll
            for (int jj = 0; jj < 4; ++jj) pk[jj] = cvt_pk_bf16(pv[8 * s + 2 * jj], pv[8 * s + 2 * jj + 1]);
            const bf16x8 pf = __builtin_bit_cast(bf16x8, pk);
            o[0] = MFMA32(vf[0][s], pf, o[0]);
            o[1] = MFMA32(vf[1][s], pf, o[1]);
        }
    }
    const float inv = __builtin_amdgcn_rcpf(lrun);
#pragma unroll
    for (int d = 0; d < 2; ++d)
#pragma unroll
        for (int g = 0; g < 4; ++g) {
            u32x2 pk; pk[0] = cvt_pk_bf16(o[d][4 * g] * inv, o[d][4 * g + 1] * inv); pk[1] = cvt_pk_bf16(o[d][4 * g + 2] * inv, o[d][4 * g + 3] * inv);
            *(u32x2*)(yp + d * 32 + 8 * g + 4 * h) = pk;
        }
}

DEVINL void group_barrier(unsigned* word, unsigned target) {
    asm volatile("s_waitcnt vmcnt(0) lgkmcnt(0)" ::: "memory");
    __syncthreads();
    if (threadIdx.x == 0) {
        __builtin_amdgcn_fence(__ATOMIC_RELEASE, "agent");
        __hip_atomic_fetch_add(word, 1u, __ATOMIC_RELAXED, __HIP_MEMORY_SCOPE_AGENT);
        while (__hip_atomic_load(word, __ATOMIC_RELAXED, __HIP_MEMORY_SCOPE_AGENT) < target) __builtin_amdgcn_s_sleep(2);
        __builtin_amdgcn_fence(__ATOMIC_ACQUIRE, "agent");
        asm volatile("s_waitcnt vmcnt(0)" ::: "memory");
    }
    __syncthreads();
}
DEVINL void partial_merge(const Ctx& c, unsigned char* lds, int idx, int nblk);
DEVINL void phase_mixers(const Ctx& c, int layer, unsigned char* lds) {
    const int bx = BID, G = gridDim.x;
    unsigned* cnts = (unsigned*)(c.ws + WS_END + 1024);
    if (bx < 64) { rwkv_scan(c, layer, bx >> 3, bx & 7, cnts + bx * 3, bx < 32 ? 3 : 2, (float*)lds); return; }
    if (bx < 96) ret_block(c, (bx - 64) >> 2, (bx - 64) & 3, lds);
    else {
        if (bx < 256) {
            const int idx = bx - 96;
            int head, pj, nP;
            if (idx < 96) { head = idx / 3; pj = idx - head * 3; nP = 3; } else { const int j = idx - 96; head = 32 + (j >> 1); pj = j & 1; nP = 2; }
            rw_project_head(c, layer, head >> 3, head & 7, pj, nP, cnts + head * 3 + pj, lds);
        }
        const int nw = (G - 96) * (NTHR / 64), wid = (bx - 96) * (NTHR / 64) + (TID >> 6);
        const int NSB = 68 * 64;
        for (int i = wid; i < 2 * NSB; i += nw) {
            if (i < NSB) { const int qg = 67 - i / 64, bh = i & 63; sb_task(c, bh >> 3, bh & 7, qg); }
            else { const int i2 = i - NSB; const int qg = 67 - i2 / 64, bh = i2 & 63; swa_task(c, layer, bh >> 3, bh & 7, qg); }
        }
    }
    group_barrier((unsigned*)(c.ws + WS_END + 768), (unsigned)((layer + 1) * (G - 64)));
    partial_merge(c, lds, bx - 64, G - 64);
}

DEVINL float* mp_row(const Ctx& c, int t) { return (float*)(c.Z() + (size_t)t * ZW); }
template <int NI, int MODE>
DEVINL void merge_tile(const Ctx& c, unsigned char* lds, int m0, int n0) {
    const int lane = TID & 63, w = TID >> 6, wm = w & 3, wn = w >> 2, r = lane & 31, h = lane >> 5;
    f32x16 mer[NI][2]; zero_acc(mer);
    const int mbase = m0 + wm * 64, nbase = n0 + wn * 32 * NI;
#pragma unroll 1
    for (int bi = 0; bi < (MODE == 0 ? 3 : 1); ++bi) {
        const int br = (MODE == 0) ? (bi == 2 ? 3 : bi) : 2;
        f32x16 acc[NI][2]; zero_acc(acc);
        gemm_kloop<NI>(c.Y() + (size_t)br * T * 512, 512, c.Pbr() + (size_t)br * DM * 512, 512, 512, m0, n0, lds, acc);
#pragma unroll
        for (int mi = 0; mi < 2; ++mi) {
            const bf16_t* gp = c.Z() + (size_t)(mbase + mi * 32 + r) * ZW + Z_GZ + br * DM + nbase;
#pragma unroll
            for (int ni = 0; ni < NI; ++ni)
#pragma unroll
                for (int g = 0; g < 4; ++g) {
                    const u32x2 gg = *(const u32x2*)(gp + ni * 32 + 8 * g + 4 * h);
                    mer[ni][mi][4 * g + 0] += bflo(gg[0]) * acc[ni][mi][4 * g + 0];
                    mer[ni][mi][4 * g + 1] += bfhi(gg[0]) * acc[ni][mi][4 * g + 1];
                    mer[ni][mi][4 * g + 2] += bflo(gg[1]) * acc[ni][mi][4 * g + 2];
                    mer[ni][mi][4 * g + 3] += bfhi(gg[1]) * acc[ni][mi][4 * g + 3];
                }
        }
    }
    if (MODE == 0) {
#pragma unroll
        for (int mi = 0; mi < 2; ++mi) {
            float* pp = mp_row(c, mbase + mi * 32 + r) + nbase;
#pragma unroll
            for (int ni = 0; ni < NI; ++ni)
#pragma unroll
                for (int g = 0; g < 4; ++g) {
                    f32x4 v = {mer[ni][mi][4 * g], mer[ni][mi][4 * g + 1], mer[ni][mi][4 * g + 2], mer[ni][mi][4 * g + 3]};
                    *(f32x4*)(pp + ni * 32 + 8 * g + 4 * h) = v;
                }
        }
        return;
    }
#pragma unroll
    for (int mi = 0; mi < 2; ++mi) {
        const float* pp = mp_row(c, mbase + mi * 32 + r) + nbase;
#pragma unroll
        for (int ni = 0; ni < NI; ++ni)
#pragma unroll
            for (int g = 0; g < 4; ++g) {
                const f32x4 v = *(const f32x4*)(pp + ni * 32 + 8 * g + 4 * h);
#pragma unroll
                for (int j = 0; j < 4; ++j) mer[ni][mi][4 * g + j] += v[j];
            }
    }
    if (NI == 2) {
        u32x2 pkm[2][2][4];
#pragma unroll
        for (int mi = 0; mi < 2; ++mi)
#pragma unroll
            for (int ni = 0; ni < 2; ++ni)
#pragma unroll
                for (int g = 0; g < 4; ++g) { pkm[mi][ni][g][0] = cvt_pk_bf16(mer[ni % NI][mi][4 * g], mer[ni % NI][mi][4 * g + 1]); pkm[mi][ni][g][1] = cvt_pk_bf16(mer[ni % NI][mi][4 * g + 2], mer[ni % NI][mi][4 * g + 3]); }
        store_rows_via_lds(lds, pkm, c.M() + (size_t)mbase * DM + nbase, DM);
    } else {
#pragma unroll
        for (int mi = 0; mi < 2; ++mi) {
            bf16_t* mp = c.M() + (size_t)(mbase + mi * 32 + r) * DM + nbase;
#pragma unroll
            for (int g = 0; g < 4; ++g) {
                u32x2 pk; pk[0] = cvt_pk_bf16(mer[0][mi][4 * g], mer[0][mi][4 * g + 1]); pk[1] = cvt_pk_bf16(mer[0][mi][4 * g + 2], mer[0][mi][4 * g + 3]);
                *(u32x2*)(mp + 8 * g + 4 * h) = pk;
            }
        }
    }
}
DEVINL void partial_merge(const Ctx& c, unsigned char* lds, int idx, int nblk) {
    const int MT = T / 256, NT = DM / 128, total = MT * NT;
    if ((nblk & 7) == 0 && NT == 8) {
        const int x = idx & 7, local = idx >> 3, per = nblk >> 3;
        for (int j = local; ; j += per) {
            const int tm = x + 8 * (j >> 3), tn = j & 7;
            if (tm >= MT) break;
            merge_tile<2, 0>(c, lds, tm * 256, tn * 128);
        }
        return;
    }
    for (int q = idx; q < total; q += nblk) {
        int tm, tn; tile_of(q, MT, NT, tm, tn);
        merge_tile<2, 0>(c, lds, tm * 256, tn * 128);
    }
}
DEVINL void phase_merge(const Ctx& c, unsigned char* lds) {
    const int MT = T / 256, NT = DM / 128, total = MT * NT, G = gridDim.x, slot = slot_of_block();
    const int nfull = (total / G) * G, rem = total - nfull;
    const bool halves = rem > 0 && 2 * rem <= G;
    for (int q = slot; q < (halves ? nfull : total); q += G) {
        int tm, tn; tile_of(q, MT, NT, tm, tn);
        merge_tile<2, 1>(c, lds, tm * 256, tn * 128);
    }
    if (halves && slot < 2 * rem) {
        int tm, tn; tile_of(nfull + (slot >> 1), MT, NT, tm, tn);
        merge_tile<1, 1>(c, lds, tm * 256, tn * 128 + (slot & 1) * 64);
    }
}

template <int NI>
DEVINL void resid_tile(const Ctx& c, const bf16_t* A, int K, const bf16_t* Bt, unsigned char* lds, int m0, int n0, bool dostore) {
    const int lane = TID & 63, w = TID >> 6, wm = w & 3, wn = w >> 2, r = lane & 31, h = lane >> 5;
    f32x16 acc[NI][2]; zero_acc(acc);
    gemm_kloop<NI>(A, K, Bt, K, K, m0, n0, lds, acc);
    const int mbase = m0 + wm * 64, nbase = n0 + wn * 32 * NI;
#pragma unroll
    for (int mi = 0; mi < 2; ++mi) {
        float* xp = xrow(c, mbase + mi * 32 + r) + nbase;
#pragma unroll
        for (int ni = 0; ni < NI; ++ni)
#pragma unroll
            for (int g = 0; g < 4; ++g) {
                f32x4 v = *(f32x4*)(xp + ni * 32 + 8 * g + 4 * h);
#pragma unroll
                for (int j = 0; j < 4; ++j) v[j] += acc[ni][mi][4 * g + j];
                if (dostore || v[0] != v[0]) *(f32x4*)(xp + ni * 32 + 8 * g + 4 * h) = v;
            }
    }
}
DEVINL void phase_gemm_resid(const Ctx& c, const bf16_t* A, int K, const bf16_t* Bt, unsigned char* lds, bool dostore = true) {
    const int MT = T / 256, NT = DM / 128, total = MT * NT, G = gridDim.x, slot = slot_of_block();
    const int nfull = (total / G) * G, rem = total - nfull;
    const bool halves = rem > 0 && 2 * rem <= G;
    for (int q = slot; q < (halves ? nfull : total); q += G) {
        int tm, tn; tile_of(q, MT, NT, tm, tn);
        resid_tile<2>(c, A, K, Bt, lds, tm * 256, tn * 128, dostore);
    }
    if (halves && slot < 2 * rem) {
        int tm, tn; tile_of(nfull + (slot >> 1), MT, NT, tm, tn);
        resid_tile<1>(c, A, K, Bt, lds, tm * 256, tn * 128 + (slot & 1) * 64, dostore);
    }
}

DEVINL void phase_up(const Ctx& c, unsigned char* lds) {
    const int MT = T / 256, NT = DFF / 128, total = MT * NT, G = gridDim.x, slot = slot_of_block();
    const int lane = TID & 63, w = TID >> 6, wm = w & 3, wn = w >> 2, r = lane & 31, h = lane >> 5;
    const int nfull = (total / G) * G, rem = total - nfull;
    const bool halves = rem > 0 && 2 * rem <= G;
    if (halves && slot < 2 * rem) {
        int tm, tn; tile_of(nfull + (slot >> 1), MT, NT, tm, tn);
        const int n0 = tn * 128 + (slot & 1) * 64;
        f32x16 acc1[1][2]; zero_acc(acc1);
        gemm_kloop<1>(c.H(), DM, c.Wup(), DM, DM, tm * 256, n0, lds, acc1);
        const int mbase = tm * 256 + wm * 64, nb = n0 + wn * 32;
#pragma unroll
        for (int mi = 0; mi < 2; ++mi) {
            bf16_t* up = c.U() + (size_t)(mbase + mi * 32 + r) * DFF + nb;
#pragma unroll
            for (int g = 0; g < 4; ++g) {
                float v[4];
#pragma unroll
                for (int j = 0; j < 4; ++j) { const float a = fmaxf(acc1[0][mi][4 * g + j], 0.f); v[j] = a * a; }
                u32x2 o; o[0] = cvt_pk_bf16(v[0], v[1]); o[1] = cvt_pk_bf16(v[2], v[3]);
                *(u32x2*)(up + 8 * g + 4 * h) = o;
            }
        }
    }
    for (int q = slot; q < (halves ? nfull : total); q += G) {
        int tm, tn; tile_of(q, MT, NT, tm, tn);
        f32x16 acc[2][2]; zero_acc(acc);
        gemm_kloop(c.H(), DM, c.Wup(), DM, DM, tm * 256, tn * 128, lds, acc);
        const int mbase = tm * 256 + wm * 64, nbase = tn * 128 + wn * 64;
        {
            u32x2 pku[2][2][4];
#pragma unroll
            for (int mi = 0; mi < 2; ++mi)
#pragma unroll
                for (int ni = 0; ni < 2; ++ni)
#pragma unroll
                    for (int g = 0; g < 4; ++g) {
                        float v[4];
#pragma unroll
                        for (int j = 0; j < 4; ++j) { const float a = fmaxf(acc[ni][mi][4 * g + j], 0.f); v[j] = a * a; }
                        pku[mi][ni][g][0] = cvt_pk_bf16(v[0], v[1]); pku[mi][ni][g][1] = cvt_pk_bf16(v[2], v[3]);
                    }
            store_rows_via_lds(lds, pku, c.U() + (size_t)mbase * DFF + nbase, DFF);
        }
    }
}

DEVINL void grid_barrier(unsigned* bar, unsigned epoch) {
    asm volatile("s_waitcnt vmcnt(0) lgkmcnt(0)" ::: "memory");
    __syncthreads();
    if (threadIdx.x == 0) {
        __builtin_amdgcn_fence(__ATOMIC_RELEASE, "agent");
        const unsigned G = gridDim.x;
        if ((G & 7u) == 0u) {
            const unsigned g = blockIdx.x & 7u, ng = G >> 3;
            const unsigned old = __hip_atomic_fetch_add(bar + 16 * (1 + g), 1u, __ATOMIC_RELAXED, __HIP_MEMORY_SCOPE_AGENT);
            if (old + 1u == epoch * ng) __hip_atomic_fetch_add(bar, 1u, __ATOMIC_RELAXED, __HIP_MEMORY_SCOPE_AGENT);
            while (__hip_atomic_load(bar, __ATOMIC_RELAXED, __HIP_MEMORY_SCOPE_AGENT) < epoch * 8u) __builtin_amdgcn_s_sleep(1);
        } else {
            __hip_atomic_fetch_add(bar, 1u, __ATOMIC_RELAXED, __HIP_MEMORY_SCOPE_AGENT);
            while (__hip_atomic_load(bar, __ATOMIC_RELAXED, __HIP_MEMORY_SCOPE_AGENT) < epoch * G) __builtin_amdgcn_s_sleep(1);
        }
        __builtin_amdgcn_fence(__ATOMIC_ACQUIRE, "agent");
        asm volatile("s_waitcnt vmcnt(0)" ::: "memory");
    }
    __syncthreads();
}

constexpr int LDS_BYTES = 3 * STAGE;
constexpr int PH_PER_LAYER = 8, N_PHASES = 1 + DEPTH * PH_PER_LAYER;

__global__ void __launch_bounds__(NTHR) fwd_megakernel(Params P) {
    extern __shared__ __attribute__((aligned(16))) unsigned char lds[];
    cg::grid_group grid = cg::this_grid();
    Ctx c;
    c.in = P.in; c.ws = P.ws; c.out = P.out;
    const int lo = P.ph_lo, hi = P.ph_hi;
    unsigned epoch = 0;
    if (hi < 0) grid.sync();
    for (int ph = lo; ph < hi; ++ph) {
        if (ph == 0) phase_init(c);
        else {
            const int layer = (ph - 1) / PH_PER_LAYER, sub = (ph - 1) % PH_PER_LAYER;
#ifdef PROBE_SUB
#define PROBE_LAST (rep == ((sub == PROBE_SUB || PROBE_SUB == 99) ? 1 : 0))
            for (int rep = 0; rep < ((sub == PROBE_SUB || PROBE_SUB == 99) ? 2 : 1); ++rep)
#else
#define PROBE_LAST true
#endif
            switch (sub) {
                case 0: phase_norm(c, c.in[I_N1G] + layer * DM, true); phase_cvt(c, layer, (float*)lds); break;
                case 1:
#ifdef PROBE_TRIV
                    phase_inproj(c, layer, lds, true);
#endif
                    phase_inproj(c, layer, lds); break;
                case 2: phase_mixers(c, layer, lds); break;
                case 3: phase_merge(c, lds); break;
                case 4: phase_gemm_resid(c, c.M(), DM, c.Wo(), lds, PROBE_LAST); break;
                case 5: phase_norm(c, c.in[I_N2G] + layer * DM, false); break;
                case 6: phase_up(c, lds); break;
                case 7: phase_gemm_resid(c, c.U(), DFF, c.Wdn(), lds, PROBE_LAST); break;
            }
        }
        if (ph + 1 < hi) {
#if MULTI_LAUNCH
            grid.sync();
#else
#ifdef PROBE_BAR
            for (int rb = 0; rb < PROBE_BAR; ++rb) grid_barrier((unsigned*)(c.ws + WS_END), ++epoch);
#endif
            grid_barrier((unsigned*)(c.ws + WS_END), ++epoch);
#endif
        }
    }
}

extern "C" void kernel_launch(void* const* d_in, const int* in_sizes, int n_in, void* d_out, int out_size, void* d_ws, size_t ws_size, hipStream_t stream) {
    static int grid_blocks = 0;
    if (!grid_blocks) {
        int dev = 0, cus = 0, per_cu = 0;
        hipGetDevice(&dev);
        hipDeviceGetAttribute(&cus, hipDeviceAttributeMultiprocessorCount, dev);
        hipFuncSetAttribute((const void*)fwd_megakernel, hipFuncAttributeMaxDynamicSharedMemorySize, LDS_BYTES);
        hipOccupancyMaxActiveBlocksPerMultiprocessor(&per_cu, (const void*)fwd_megakernel, NTHR, LDS_BYTES);
        if (per_cu < 1) per_cu = 1;
        grid_blocks = cus * per_cu;
        if (grid_blocks > 256) grid_blocks = 256;
        if (ws_size < WS_END) fprintf(stderr, "kernel_launch: workspace too small: %zu < %zu\n", ws_size, (size_t)WS_END);
        if (n_in != N_INPUTS) fprintf(stderr, "kernel_launch: expected %d inputs, got %d\n", (int)N_INPUTS, n_in);
    }
    Params p{};
    for (int i = 0; i < N_INPUTS; ++i) p.in[i] = (const float*)d_in[i];
    p.out = (float*)d_out; p.ws = (unsigned char*)d_ws;
#if MULTI_LAUNCH
    for (int ph = 0; ph < N_PHASES; ++ph) {
        p.ph_lo = ph; p.ph_hi = ph + 1;
        hipLaunchKernelGGL(fwd_megakernel, dim3(grid_blocks), dim3(NTHR), LDS_BYTES, stream, p);
    }
#else
    p.ph_lo = 0; p.ph_hi = N_PHASES;
    hipMemsetAsync((unsigned char*)d_ws + WS_END, 0, 2048, stream);
    void* args[] = {&p};
    hipError_t e = hipLaunchCooperativeKernel((const void*)fwd_megakernel, dim3(grid_blocks), dim3(NTHR), args, LDS_BYTES, stream);
    if (e != hipSuccess) fprintf(stderr, "cooperative launch failed: %s (grid %d)\n", hipGetErrorString(e), grid_blocks);
#endif
}
```

```cpp
#include <hip/hip_runtime.h>
#include <hip/hip_cooperative_groups.h>
#include <cstdio>
namespace cg = cooperative_groups;

typedef unsigned short bf16_t;
typedef short bf16x8 __attribute__((ext_vector_type(8)));
typedef float f32x16 __attribute__((ext_vector_type(16)));
typedef float f32x4 __attribute__((ext_vector_type(4)));
typedef unsigned u32x2 __attribute__((ext_vector_type(2)));
typedef unsigned u32x4 __attribute__((ext_vector_type(4)));

#define DEVINL __device__ __forceinline__
#define MFMA32(a, b, c) __builtin_amdgcn_mfma_f32_32x32x16_bf16((a), (b), (c), 0, 0, 0)

constexpr int NB = 8, SEQ = 2048, L = 2176, T = NB * L, DM = 1024, DEPTH = 4;
constexpr int NZP = 9856, ZW = 8704, DFF = 4096;
constexpr int NTHR = 512;
#define MULTI_LAUNCH 0
constexpr int Z_AQ = 0, Z_AK = 512, Z_BQ = 1024, Z_BK = 1280, Z_BG = 1536, Z_C = 2048, Z_DQ = 3840, Z_DK = 4352, Z_GZ = 4480, Z_VL = 8576;
constexpr float LOG2E = 1.4426950408889634f;
constexpr float QS = 0.125f * LOG2E;

enum { I_X = 0, I_META, I_N1G, I_WIN, I_MU, I_W0, I_W2, I_A0, I_A2, I_G2, I_KKW, I_KAW, I_RK, I_LNG, I_LNB, I_V0, I_V1, I_V2,
       I_QNG, I_KNG, I_SINK, I_PSB, I_PRET, I_PRW, I_PSW, I_WO, I_N2G, I_WUP, I_WDN, N_INPUTS };

constexpr size_t SZ_WIN = (size_t)NZP * DM * 2, SZ_PBR = (size_t)4 * DM * 512 * 2, SZ_WO = (size_t)DM * DM * 2, SZ_WUP = (size_t)DFF * DM * 2, SZ_WDN = SZ_WUP;
constexpr size_t SZ_Z = (size_t)T * ZW * 2, SZ_A512 = (size_t)T * 512 * 2;
constexpr size_t OFF_WIN = 0, OFF_PBR = OFF_WIN + SZ_WIN, OFF_WO = OFF_PBR + SZ_PBR, OFF_WUP = OFF_WO + SZ_WO, OFF_WDN = OFF_WUP + SZ_WUP,
                 OFF_Z = OFF_WDN + SZ_WDN, OFF_AVT = OFF_Z + SZ_Z, OFF_BVT = OFF_AVT + SZ_A512, OFF_DVT = OFF_BVT + SZ_A512,
                 OFF_BKT = OFF_DVT + (size_t)T * 128 * 2, OFF_RW = OFF_BKT + (size_t)T * 256 * 2, OFF_Y = OFF_RW + 7 * SZ_A512,
                 OFF_VF = OFF_Y + 4 * SZ_A512, OFF_XL = OFF_VF + SZ_A512, WS_END = OFF_XL + (size_t)NB * 128 * DM * 4;

struct Params {
    const float* in[N_INPUTS];
    float* out;
    unsigned char* ws;
    int ph_lo, ph_hi;
};

struct Ctx {
    const float* const* in;
    unsigned char* ws;
    float* out;
    DEVINL bf16_t* Win() const { return (bf16_t*)(ws + OFF_WIN); }
    DEVINL bf16_t* Pbr() const { return (bf16_t*)(ws + OFF_PBR); }
    DEVINL bf16_t* Wo() const { return (bf16_t*)(ws + OFF_WO); }
    DEVINL bf16_t* Wup() const { return (bf16_t*)(ws + OFF_WUP); }
    DEVINL bf16_t* Wdn() const { return (bf16_t*)(ws + OFF_WDN); }
    DEVINL bf16_t* Z() const { return (bf16_t*)(ws + OFF_Z); }
    DEVINL bf16_t* U() const { return (bf16_t*)(ws + OFF_Z); }
    DEVINL bf16_t* AVT() const { return (bf16_t*)(ws + OFF_AVT); }
    DEVINL bf16_t* BVT() const { return (bf16_t*)(ws + OFF_BVT); }
    DEVINL bf16_t* DVT() const { return (bf16_t*)(ws + OFF_DVT); }
    DEVINL bf16_t* BKT() const { return (bf16_t*)(ws + OFF_BKT); }
    DEVINL bf16_t* RW() const { return (bf16_t*)(ws + OFF_RW); }
    DEVINL bf16_t* H() const { return (bf16_t*)(ws + OFF_RW); }
    DEVINL bf16_t* M() const { return (bf16_t*)(ws + OFF_RW + 2 * SZ_A512); }
    DEVINL bf16_t* Y() const { return (bf16_t*)(ws + OFF_Y); }
    DEVINL bf16_t* VF() const { return (bf16_t*)(ws + OFF_VF); }
    DEVINL float* xlead() const { return (float*)(ws + OFF_XL); }
};

DEVINL int opq_v(int x) { asm volatile("" : "+v"(x)); return x; }
DEVINL int opq_s(int x) { asm volatile("" : "+s"(x)); return x; }
#define TID (opq_v((int)threadIdx.x))
#define BID (opq_s((int)blockIdx.x))
typedef float f32x2 __attribute__((ext_vector_type(2)));
typedef __bf16 bf16x2v __attribute__((ext_vector_type(2)));
DEVINL unsigned cvt_pk_bf16(float lo, float hi) { const f32x2 v = {lo, hi}; return __builtin_bit_cast(unsigned, __builtin_convertvector(v, bf16x2v)); }
DEVINL bf16_t f2bf(float f) { return (bf16_t)(cvt_pk_bf16(f, 0.f) & 0xffffu); }
DEVINL float bf2f(bf16_t v) { return __uint_as_float(((unsigned)v) << 16); }
DEVINL float bflo(unsigned u) { return __uint_as_float(u << 16); }
DEVINL float bfhi(unsigned u) { return __uint_as_float(u & 0xffff0000u); }
DEVINL float fexp2(float x) { return __builtin_amdgcn_exp2f(x); }
DEVINL float flog2(float x) { return __builtin_amdgcn_logf(x); }
DEVINL float sigmoidf_(float x) { return __builtin_amdgcn_rcpf(1.f + fexp2(-x * LOG2E)); }
DEVINL float wave_sum(float v) {
#pragma unroll
    for (int o = 32; o >= 1; o >>= 1) v += __shfl_xor(v, o);
    return v;
}
#define DPPF(v, ctrl) __int_as_float(__builtin_amdgcn_update_dpp(0, __float_as_int(v), (ctrl), 0xF, 0xF, true))
DEVINL float wave_sum_dpp(float v) {
    v += DPPF(v, 0xB1); v += DPPF(v, 0x4E); v += DPPF(v, 0x141); v += DPPF(v, 0x140);
    const int iv = __float_as_int(v);
    return (__int_as_float(__builtin_amdgcn_readlane(iv, 0)) + __int_as_float(__builtin_amdgcn_readlane(iv, 16))) +
           (__int_as_float(__builtin_amdgcn_readlane(iv, 32)) + __int_as_float(__builtin_amdgcn_readlane(iv, 48)));
}
DEVINL float quad_sum(float v) {
    v += __int_as_float(__builtin_amdgcn_update_dpp(0, __float_as_int(v), 0xB1, 0xF, 0xF, true));
    v += __int_as_float(__builtin_amdgcn_update_dpp(0, __float_as_int(v), 0x4E, 0xF, 0xF, true));
    return v;
}
DEVINL float* xrow(const Ctx& c, int t) {
    const int b = t / L, p = t - b * L;
    return p < 128 ? c.xlead() + (size_t)(b * 128 + p) * DM : c.out + ((size_t)b * SEQ + (p - 128)) * DM;
}
DEVINL int slot_of_block() {
    const int G = gridDim.x, bx = BID;
    return (G % 8 == 0) ? (bx % 8) * (G / 8) + bx / 8 : bx;
}
#ifndef TILE_GW
#define TILE_GW 8
#endif
DEVINL void tile_of(int q, int MT, int NT, int& m, int& n) {
    const int per = MT * TILE_GW, ng = q / per, rem = q - ng * per;
    int nw = NT - ng * TILE_GW; nw = nw > TILE_GW ? TILE_GW : nw;
    m = rem / nw; n = ng * TILE_GW + rem % nw;
}

DEVINL void phase_init(const Ctx& c) {
    const float* x = c.in[I_X]; const float* meta = c.in[I_META];
    const int total = T * (DM / 4);
    for (int idx = BID * NTHR + TID; idx < total; idx += gridDim.x * NTHR) {
        const int t = idx >> 8, c4 = (idx & 255) * 4;
        const int b = t / L, p = t - b * L;
        f32x4 v = {0.f, 0.f, 0.f, 0.f};
        if (p >= 128) v = *(const f32x4*)(x + ((size_t)b * SEQ + (p - 128)) * DM + c4);
        else if (p >= 112) v = *(const f32x4*)(meta + (size_t)(p - 112) * DM + c4);
        *(f32x4*)(xrow(c, t) + c4) = v;
    }
}

DEVINL void cvt_mat(const float* __restrict__ src, int K, int N, bf16_t* __restrict__ dst, float* lds) {
    const int kt = K / 64, ntl = (N + 63) / 64, total = kt * ntl;
    const int tid = TID, G = gridDim.x;
    float v[8];
    int tile = BID;
    if (tile < total) {
        const int k0 = (tile / ntl) * 64, n0 = (tile % ntl) * 64;
#pragma unroll
        for (int i = 0; i < 8; ++i) { const int e = tid + i * NTHR, k = e >> 6, n = e & 63; v[i] = (n0 + n < N) ? src[(size_t)(k0 + k) * N + n0 + n] : 0.f; }
    }
    for (; tile < total; tile += G) {
        const int k0 = (tile / ntl) * 64, n0 = (tile % ntl) * 64;
        __syncthreads();
#pragma unroll
        for (int i = 0; i < 8; ++i) { const int e = tid + i * NTHR; lds[(e >> 6) * 65 + (e & 63)] = v[i]; }
        __syncthreads();
        if (tile + G < total) {
            const int t2 = tile + G, k2 = (t2 / ntl) * 64, n2 = (t2 % ntl) * 64;
#pragma unroll
            for (int i = 0; i < 8; ++i) { const int e = tid + i * NTHR, k = e >> 6, n = e & 63; v[i] = (n2 + n < N) ? src[(size_t)(k2 + k) * N + n2 + n] : 0.f; }
        }
        for (int e = tid; e < 2048; e += NTHR) {
            const int n = e >> 5, kk = (e & 31) * 2;
            if (n0 + n < N) *(unsigned*)(dst + (size_t)(n0 + n) * K + k0 + kk) = cvt_pk_bf16(lds[kk * 65 + n], lds[(kk + 1) * 65 + n]);
        }
    }
}
DEVINL void phase_cvt(const Ctx& c, int l, float* lds) {
    cvt_mat(c.in[I_WIN] + (size_t)l * DM * 9728, DM, 9728, c.Win(), lds);
    if (l > 0) cvt_mat(c.in[I_V1] + (size_t)(l - 1) * DM * 32, DM, 32, c.Win() + (size_t)9728 * DM, lds);
    {
        const int r0 = 9728 + (l > 0 ? 32 : 0), n = (NZP - r0) * DM / 8;
        u32x4 z = {0u, 0u, 0u, 0u};
        for (int i = BID * NTHR + TID; i < n; i += gridDim.x * NTHR) *(u32x4*)(c.Win() + (size_t)r0 * DM + (size_t)i * 8) = z;
    }
    cvt_mat(c.in[I_PSB] + (size_t)l * 512 * DM, 512, DM, c.Pbr(), lds);
    cvt_mat(c.in[I_PRET] + (size_t)l * 512 * DM, 512, DM, c.Pbr() + (size_t)DM * 512, lds);
    cvt_mat(c.in[I_PRW] + (size_t)l * 512 * DM, 512, DM, c.Pbr() + (size_t)2 * DM * 512, lds);
    cvt_mat(c.in[I_PSW] + (size_t)l * 512 * DM, 512, DM, c.Pbr() + (size_t)3 * DM * 512, lds);
    cvt_mat(c.in[I_WO] + (size_t)l * DM * DM, DM, DM, c.Wo(), lds);
    cvt_mat(c.in[I_WUP] + (size_t)l * DM * DFF, DM, DFF, c.Wup(), lds);
    cvt_mat(c.in[I_WDN] + (size_t)l * DFF * DM, DFF, DM, c.Wdn(), lds);
}

DEVINL void phase_norm(const Ctx& c, const float* __restrict__ g, bool mask_pads) {
    const int lane = TID & 63, wid = (BID * NTHR + TID) >> 6, nw = gridDim.x * (NTHR / 64);
    f32x4 gv[4];
#pragma unroll
    for (int i = 0; i < 4; ++i) gv[i] = *(const f32x4*)(g + i * 256 + lane * 4);
    for (int t = wid; t < T; t += nw) {
        const int p = t % L;
        bf16_t* hp = c.H() + (size_t)t * DM;
        if (mask_pads && p < 112) {
            u32x2 z = {0u, 0u};
#pragma unroll
            for (int i = 0; i < 4; ++i) *(u32x2*)(hp + i * 256 + lane * 4) = z;
            continue;
        }
        const float* xp = xrow(c, t);
        f32x4 v[4]; float ss = 0.f;
#pragma unroll
        for (int i = 0; i < 4; ++i) { v[i] = *(const f32x4*)(xp + i * 256 + lane * 4); ss += v[i][0] * v[i][0] + v[i][1] * v[i][1] + v[i][2] * v[i][2] + v[i][3] * v[i][3]; }
        ss = wave_sum(ss);
        const float rs = rsqrtf(ss * (1.f / DM) + 1e-6f);
#pragma unroll
        for (int i = 0; i < 4; ++i) {
            u32x2 o; o[0] = cvt_pk_bf16(v[i][0] * rs * gv[i][0], v[i][1] * rs * gv[i][1]); o[1] = cvt_pk_bf16(v[i][2] * rs * gv[i][2], v[i][3] * rs * gv[i][3]);
            *(u32x2*)(hp + i * 256 + lane * 4) = o;
        }
    }
}

#define LAS __attribute__((address_space(3)))
constexpr int LROW = 144;
constexpr int A_ST = 256 * 128, B_ST = 128 * 128, STAGE = A_ST + B_ST;
template <int NI>
DEVINL void gemm_kloop(const bf16_t* __restrict__ A, int lda, const bf16_t* __restrict__ Bt, int ldb, int K, int m0, int n0,
                       unsigned char* lds, f32x16 (&acc)[NI][2]) {
    const int tid = TID, lane = tid & 63, w = tid >> 6, wm = w & 3, wn = w >> 2, r = lane & 31, h = lane >> 5;
    const int lrow = tid >> 3, cg = (tid & 7) ^ ((tid >> 4) & 7);
    const bf16_t* ga = A + (size_t)(m0 + lrow) * lda + cg * 8;
    const bf16_t* gb = Bt + (size_t)(n0 + lrow) * ldb + cg * 8;
    unsigned char* da = lds + tid * 16;
    unsigned char* db = lds + A_ST + tid * 16;
#define GEMM_ISSUE(stg, kt) do { const int k0_ = (kt) * 64; \
        _Pragma("unroll") for (int i = 0; i < 4; ++i) __builtin_amdgcn_global_load_lds((const void*)(ga + (size_t)(i * 64) * lda + k0_), (LAS void*)(da + (stg) * STAGE + i * 8192), 16, 0, 0); \
        _Pragma("unroll") for (int i = 0; i < NI; ++i) __builtin_amdgcn_global_load_lds((const void*)(gb + (size_t)(i * 64) * ldb + k0_), (LAS void*)(db + (stg) * STAGE + i * 8192), 16, 0, 0); } while (0)
    const int nt = K >> 6;
    asm volatile("s_waitcnt lgkmcnt(0)" ::: "memory");
    __builtin_amdgcn_s_barrier();
    GEMM_ISSUE(0, 0);
    if (nt > 1) GEMM_ISSUE(1, 1);
    const int sw = (r >> 1) & 7;
    int o4[4];
#pragma unroll
    for (int ks = 0; ks < 4; ++ks) o4[ks] = ((ks * 2 + h) ^ sw) * 16;
    int cur = 0;
    auto compute = [&](int st_) {
        const unsigned char* pa = lds + st_ * STAGE + (wm * 64 + r) * 128;
        const unsigned char* pb = lds + st_ * STAGE + A_ST + (wn * 32 * NI + r) * 128;
        bf16x8 af[2][2], bfr[2][NI];
#pragma unroll
        for (int i = 0; i < 2; ++i) af[0][i] = *(const bf16x8*)(pa + i * 32 * 128 + o4[0]);
#pragma unroll
        for (int i = 0; i < NI; ++i) bfr[0][i] = *(const bf16x8*)(pb + i * 32 * 128 + o4[0]);
#pragma unroll
        for (int ks = 0; ks < 4; ++ks) {
            if (ks < 3) {
#pragma unroll
                for (int i = 0; i < 2; ++i) af[(ks + 1) & 1][i] = *(const bf16x8*)(pa + i * 32 * 128 + o4[ks + 1]);
#pragma unroll
                for (int i = 0; i < NI; ++i) bfr[(ks + 1) & 1][i] = *(const bf16x8*)(pb + i * 32 * 128 + o4[ks + 1]);
            }
#pragma unroll
            for (int ni = 0; ni < NI; ++ni)
#pragma unroll
                for (int mi = 0; mi < 2; ++mi) acc[ni][mi] = MFMA32(bfr[ks & 1][ni], af[ks & 1][mi], acc[ni][mi]);
        }
    };
    int t = 0;
    for (; t + 2 < nt; ++t) {
        if (NI == 2) asm volatile("s_waitcnt vmcnt(6)" ::: "memory"); else asm volatile("s_waitcnt vmcnt(5)" ::: "memory");
        __builtin_amdgcn_s_barrier();
        { const int s2 = (cur >= 1) ? cur - 1 : 2; GEMM_ISSUE(s2, t + 2); }
        compute(cur);
        cur = (cur == 2) ? 0 : cur + 1;
    }
    if (nt >= 2) {
        if (NI == 2) asm volatile("s_waitcnt vmcnt(6)" ::: "memory"); else asm volatile("s_waitcnt vmcnt(5)" ::: "memory");
        __builtin_amdgcn_s_barrier();
        compute(cur);
        cur = (cur == 2) ? 0 : cur + 1;
    }
    asm volatile("s_waitcnt vmcnt(0)" ::: "memory");
    __builtin_amdgcn_s_barrier();
    compute(cur);
#undef GEMM_ISSUE
}
template <int NA>
DEVINL void zero_acc(f32x16 (&acc)[NA][2]) {
#pragma unroll
    for (int a = 0; a < NA; ++a)
#pragma unroll
        for (int b = 0; b < 2; ++b)
#pragma unroll
            for (int i = 0; i < 16; ++i) acc[a][b][i] = 0.f;
}


DEVINL void store_rows_via_lds(unsigned char* lds, const u32x2 (&pk)[2][2][4], bf16_t* out_row0, int ld) {
    const int tid = TID, lane = tid & 63, w = tid >> 6, r = lane & 31, h = lane >> 5;
    unsigned char* reg = lds + w * (64 * 144);
    __syncthreads();
#pragma unroll
    for (int mi = 0; mi < 2; ++mi)
#pragma unroll
        for (int ni = 0; ni < 2; ++ni)
#pragma unroll
            for (int g = 0; g < 4; ++g) *(u32x2*)(reg + (mi * 32 + r) * 144 + (ni * 32 + 8 * g + 4 * h) * 2) = pk[mi][ni][g];
    __syncthreads();
#pragma unroll
    for (int it = 0; it < 8; ++it) {
        const int idx = it * 64 + lane, row = idx >> 3, c16 = idx & 7;
        const u32x4 v = *(const u32x4*)(reg + row * 144 + c16 * 16);
        *(u32x4*)(out_row0 + (size_t)row * ld + c16 * 8) = v;
    }
}


DEVINL void store_cols_via_lds(unsigned char* lds, const u32x2 (&pk)[2][2][4], bf16_t* vt_col0  ) {
    const int tid = TID, lane = tid & 63, w = tid >> 6, r = lane & 31, h = lane >> 5;
    unsigned char* reg = lds + w * (64 * 144);
    __syncthreads();
#pragma unroll
    for (int mi = 0; mi < 2; ++mi)
#pragma unroll
        for (int ni = 0; ni < 2; ++ni)
#pragma unroll
            for (int g = 0; g < 4; ++g) {
                const int n = ni * 32 + 8 * g + 4 * h, m = mi * 32 + r;
                *(bf16_t*)(reg + (n + 0) * 144 + m * 2) = (bf16_t)(pk[mi][ni][g][0] & 0xffffu);
                *(bf16_t*)(reg + (n + 1) * 144 + m * 2) = (bf16_t)(pk[mi][ni][g][0] >> 16);
                *(bf16_t*)(reg + (n + 2) * 144 + m * 2) = (bf16_t)(pk[mi][ni][g][1] & 0xffffu);
                *(bf16_t*)(reg + (n + 3) * 144 + m * 2) = (bf16_t)(pk[mi][ni][g][1] >> 16);
            }
    __syncthreads();
#pragma unroll
    for (int it = 0; it < 8; ++it) {
        const int idx = it * 64 + lane, n = idx >> 3, c16 = idx & 7;
        const u32x4 v = *(const u32x4*)(reg + n * 144 + c16 * 16);
        *(u32x4*)(vt_col0 + (size_t)n * L + c16 * 8) = v;
    }
}

DEVINL void epi_inproj(const Ctx& c, int layer, f32x16 (&acc)[2][2], int mbase, int nbase, unsigned char* lds) {
    const int lane = TID & 63, r = lane & 31, h = lane >> 5;
    const int n = nbase;
    int zc = -1, tr = 0, vcol = 0, vC = 0; bf16_t* vt = nullptr; float scale = 1.f; const float* gain = nullptr;
    if (n < 512) { zc = Z_AQ + n; scale = QS; }
    else if (n < 1024) { zc = Z_AK + (n - 512); }
    else if (n < 1536) { vt = c.AVT(); vcol = n - 1024; vC = 512; }
    else if (n < 1792) { zc = Z_BQ + (n - 1536); }
    else if (n < 2048) { zc = Z_BK + (n - 1792); scale = 0.125f; vt = c.BKT(); vcol = n - 1792; vC = 256; }
    else if (n < 2560) { vt = c.BVT(); vcol = n - 2048; vC = 512; }
    else if (n < 3072) { zc = Z_BG + (n - 2560); }
    else if (n < 4864) { zc = Z_C + (n - 3072); }
    else if (n < 5376) { zc = Z_DQ + (n - 4864); tr = 1; scale = QS; gain = c.in[I_QNG] + layer * 64; }
    else if (n < 5504) { zc = Z_DK + (n - 5376); tr = 1; gain = c.in[I_KNG] + layer * 64; }
    else if (n < 5632) { vt = c.DVT(); vcol = n - 5504; vC = 128; }
    else if (n < 9728) { zc = Z_GZ + (n - 5632); tr = 2; }
    else { zc = Z_VL + (n - 9728); }
    u32x2 pkz[2][2][4];
#pragma unroll
    for (int mi = 0; mi < 2; ++mi) {
        const int m = mbase + mi * 32 + r;
        const int b = m / L, p = m - b * L;
        float rs = scale;
        if (tr == 1) {
            float ss = 0.f;
#pragma unroll
            for (int ni = 0; ni < 2; ++ni)
#pragma unroll
                for (int i = 0; i < 16; ++i) ss += acc[ni][mi][i] * acc[ni][mi][i];
            ss += __shfl_xor(ss, 32);
            rs = rsqrtf(ss * (1.f / 64.f) + 1e-6f) * scale;
        }
#pragma unroll
        for (int ni = 0; ni < 2; ++ni)
#pragma unroll
            for (int g = 0; g < 4; ++g) {
                const int nl = ni * 32 + 8 * g + 4 * h;
                float v[4];
#pragma unroll
                for (int j = 0; j < 4; ++j) v[j] = acc[ni][mi][4 * g + j];
                if (tr == 1) {
                    const f32x4 gg = *(const f32x4*)(gain + nl);
#pragma unroll
                    for (int j = 0; j < 4; ++j) v[j] *= rs * gg[j];
                } else if (tr == 2) {
#pragma unroll
                    for (int j = 0; j < 4; ++j) v[j] = sigmoidf_(v[j]);
                } else {
#pragma unroll
                    for (int j = 0; j < 4; ++j) v[j] *= scale;
                }
                { u32x2 o; o[0] = cvt_pk_bf16(v[0], v[1]); o[1] = cvt_pk_bf16(v[2], v[3]); pkz[mi][ni][g] = o; }
            }
    }
    if (zc >= 0) store_rows_via_lds(lds, pkz, c.Z() + (size_t)mbase * ZW + zc, ZW);
    if (vt) { const int b0 = mbase / L, p0 = mbase - b0 * L; store_cols_via_lds(lds, pkz, vt + ((size_t)(b0 * vC + vcol)) * L + p0); }
}
DEVINL void phase_inproj(const Ctx& c, int layer, unsigned char* lds, bool trivial = false) {
    const int MT = T / 256, NT = NZP / 128, total = MT * NT;
    const int w = TID >> 6, wm = w & 3, wn = w >> 2;
    const int G = gridDim.x, slot = slot_of_block();
    const int nfull = (total / G) * G, rem = total - nfull;
    bool halves = rem > 0 && 2 * rem <= G && !trivial;
    if (halves) { int tm0, tn0; tile_of(nfull, MT, NT, tm0, tn0); halves = tn0 >= 44; }
    if (halves && slot < 2 * rem) {
        int tm, tn; tile_of(nfull + (slot >> 1), MT, NT, tm, tn);
        const int lane = TID & 63, r = lane & 31, h = lane >> 5;
        const int n0 = tn * 128 + (slot & 1) * 64;
        f32x16 acc1[1][2]; zero_acc(acc1);
        gemm_kloop<1>(c.H(), DM, c.Win(), DM, DM, tm * 256, n0, lds, acc1);
        const int mbase = tm * 256 + wm * 64, nb = n0 + wn * 32;
        const bool sig = nb < 9728;
        const int zc = sig ? Z_GZ + (nb - 5632) : Z_VL + (nb - 9728);
#pragma unroll
        for (int mi = 0; mi < 2; ++mi) {
            bf16_t* zp = c.Z() + (size_t)(mbase + mi * 32 + r) * ZW + zc;
#pragma unroll
            for (int g = 0; g < 4; ++g) {
                float v[4];
#pragma unroll
                for (int j = 0; j < 4; ++j) { const float a = acc1[0][mi][4 * g + j]; v[j] = sig ? sigmoidf_(a) : a; }
                u32x2 o; o[0] = cvt_pk_bf16(v[0], v[1]); o[1] = cvt_pk_bf16(v[2], v[3]);
                *(u32x2*)(zp + 8 * g + 4 * h) = o;
            }
        }
    }
    for (int q = slot; q < (halves ? nfull : total); q += G) {
        int tm, tn; tile_of(q, MT, NT, tm, tn);
        f32x16 acc[2][2]; zero_acc(acc);
        gemm_kloop<2>(c.H(), DM, c.Win(), DM, DM, tm * 256, tn * 128, lds, acc);
        if (trivial) {
            const int lane = TID & 63, r = lane & 31, h = lane >> 5;
            u32x2 pk[2][2][4];
#pragma unroll
            for (int mi = 0; mi < 2; ++mi)
#pragma unroll
                for (int ni = 0; ni < 2; ++ni)
#pragma unroll
                    for (int g = 0; g < 4; ++g) { pk[mi][ni][g][0] = cvt_pk_bf16(acc[ni][mi][4 * g], acc[ni][mi][4 * g + 1]); pk[mi][ni][g][1] = cvt_pk_bf16(acc[ni][mi][4 * g + 2], acc[ni][mi][4 * g + 3]); }
            const int zc = (tn < 68 ? tn : tn - 9) * 128 + wn * 64;
            store_rows_via_lds(lds, pk, c.Z() + (size_t)(tm * 256 + wm * 64) * ZW + zc, ZW);
        } else
        epi_inproj(c, layer, acc, tm * 256 + wm * 64, tn * 128 + wn * 64, lds);
    }
}

DEVINL void phase_rwproj(const Ctx& c, int layer, float* act) {
    const int tid = TID, col = tid;
    const float* mu = c.in[I_MU] + layer * 1792;
    const float mu_r = mu[col], mu_k = mu[512 + col], mu_v = mu[1024 + col];
    const float w0c = c.in[I_W0][layer * 512 + col], a0c = c.in[I_A0][layer * 512 + col];
    const float kkc = c.in[I_KKW][layer * 512 + col], kac = c.in[I_KAW][layer * 512 + col];
    const float v0c = layer > 0 ? c.in[I_V0][(layer - 1) * 512 + col] : 0.f;
    const float* w2 = c.in[I_W2] + (size_t)layer * 64 * 512 + col;
    const float* a2 = c.in[I_A2] + (size_t)layer * 64 * 512 + col;
    const float* g2 = c.in[I_G2] + (size_t)layer * 128 * 512 + col;
    const float* v2 = c.in[I_V2] + (size_t)(layer > 0 ? layer - 1 : 0) * 32 * 512 + col;
    bf16_t* R = c.RW(); bf16_t* LD = c.RW() + (size_t)T * 512; bf16_t* KP = c.RW() + (size_t)2 * T * 512; bf16_t* VP = c.RW() + (size_t)3 * T * 512;
    bf16_t* KK = c.RW() + (size_t)4 * T * 512; bf16_t* BB = c.RW() + (size_t)5 * T * 512; bf16_t* GG = c.RW() + (size_t)6 * T * 512;
    for (int task = BID; task < T / 8; task += gridDim.x) {
        const int t0 = task * 8;
        __syncthreads();
        for (int e = tid; e < 288 * 8; e += NTHR) {
            const int tok = e / 288, k = e - tok * 288;
            const int t = t0 + tok, p = t % L;
            float v;
            if (k < 256) {
                const int zcol = Z_C + 1536 + k;
                const float cur = bf2f(c.Z()[(size_t)t * ZW + zcol]);
                const float prev = p > 0 ? bf2f(c.Z()[(size_t)(t - 1) * ZW + zcol]) : 0.f;
                v = cur + (prev - cur) * mu[1536 + k];
                if (k < 64) v = tanhf(v); else if (k >= 128) v = sigmoidf_(v);
            } else v = bf2f(c.Z()[(size_t)t * ZW + Z_VL + (k - 256)]);
            act[k * 8 + tok] = v;
        }
        __syncthreads();
        float aw[8], aa[8], ag[8], av[8];
#pragma unroll
        for (int i = 0; i < 8; ++i) { aw[i] = 0.f; aa[i] = 0.f; ag[i] = 0.f; av[i] = 0.f; }
        for (int k = 0; k < 64; ++k) {
            const float wv = w2[(size_t)k * 512], avv = a2[(size_t)k * 512];
#pragma unroll
            for (int q4 = 0; q4 < 2; ++q4) {
                const f32x4 x = *(const f32x4*)(act + k * 8 + q4 * 4), y = *(const f32x4*)(act + (64 + k) * 8 + q4 * 4);
#pragma unroll
                for (int j = 0; j < 4; ++j) { aw[q4 * 4 + j] += wv * x[j]; aa[q4 * 4 + j] += avv * y[j]; }
            }
        }
        for (int k = 0; k < 128; ++k) {
            const float gv = g2[(size_t)k * 512];
#pragma unroll
            for (int q4 = 0; q4 < 2; ++q4) {
                const f32x4 x = *(const f32x4*)(act + (128 + k) * 8 + q4 * 4);
#pragma unroll
                for (int j = 0; j < 4; ++j) ag[q4 * 4 + j] += gv * x[j];
            }
        }
        if (layer > 0) {
            for (int k = 0; k < 32; ++k) {
                const float vv = v2[(size_t)k * 512];
#pragma unroll
                for (int q4 = 0; q4 < 2; ++q4) {
                    const f32x4 x = *(const f32x4*)(act + (256 + k) * 8 + q4 * 4);
#pragma unroll
                    for (int j = 0; j < 4; ++j) av[q4 * 4 + j] += vv * x[j];
                }
            }
        }
#pragma unroll
        for (int tok = 0; tok < 8; ++tok) {
            const int t = t0 + tok, p = t % L;
            const bf16_t* zr = c.Z() + (size_t)t * ZW + Z_C + col;
            float rc = bf2f(zr[0]), kc = bf2f(zr[512]), vc = bf2f(zr[1024]);
            float rp = 0.f, kp = 0.f, vp = 0.f;
            if (p > 0) { rp = bf2f(zr[-ZW]); kp = bf2f(zr[512 - ZW]); vp = bf2f(zr[1024 - ZW]); }
            rc += (rp - rc) * mu_r; kc += (kp - kc) * mu_k; vc += (vp - vc) * mu_v;
            const float u = -(w0c + aw[tok]);
            const float spl = fmaxf(u, 0.f) + __logf(1.f + __expf(-fabsf(u)));
            const float wlog = -spl - 0.5f;
            const float ld = -__expf(wlog);
            const float a = sigmoidf_(a0c + aa[tok]);
            const float kkraw = kc * kkc;
            const float ss = wave_sum(kkraw * kkraw);
            const float kk = kkraw / fmaxf(sqrtf(ss), 1e-12f);
            const float kmod = kc * (1.f + (a - 1.f) * kac);
            const size_t o = (size_t)t * 512 + col;
            float vout = vc;
            if (layer == 0) c.VF()[o] = f2bf(vc);
            else { const float vf = bf2f(c.VF()[o]); vout = vc + (vf - vc) * sigmoidf_(v0c + av[tok]); }
            asm volatile("" ::: "memory");
            R[o] = f2bf(rc); LD[o] = f2bf(ld * LOG2E); KP[o] = f2bf(kmod); VP[o] = f2bf(vout); KK[o] = f2bf(kk); BB[o] = f2bf(kk * a); GG[o] = f2bf(ag[tok]);
        }
    }
}

constexpr int TC = 16, NCH = L / TC, STG = 7 * TC * 64;
struct RwOps { f32x4 w[2], k[2], kk[2], b[2], r[2]; f32x2 v; };
DEVINL void rw_load_ops(RwOps& o, const float* buf, int tt, int jo, int i0) {
    const float* p = buf + tt * 64 + jo * 8;
#pragma unroll
    for (int q = 0; q < 2; ++q) {
        o.r[q] = *(const f32x4*)(p + q * 4); o.w[q] = *(const f32x4*)(p + TC * 64 + q * 4); o.k[q] = *(const f32x4*)(p + 2 * TC * 64 + q * 4);
        o.kk[q] = *(const f32x4*)(p + 4 * TC * 64 + q * 4); o.b[q] = *(const f32x4*)(p + 5 * TC * 64 + q * 4);
    }
    o.v = *(const f32x2*)(buf + 3 * TC * 64 + tt * 64 + i0);
}
DEVINL float oct_sum(float v) { v += DPPF(v, 0xB1); v += DPPF(v, 0x4E); v += DPPF(v, 0x141); return v; }
DEVINL f32x2 rw_step(f32x2 (&S0)[4], f32x2 (&S1)[4], const RwOps& o) {
    f32x2 a0 = {0.f, 0.f}, a1 = {0.f, 0.f};
#pragma unroll
    for (int p = 0; p < 4; ++p) { const f32x2 kk2 = {o.kk[p >> 1][(p & 1) * 2], o.kk[p >> 1][(p & 1) * 2 + 1]}; a0 += S0[p] * kk2; a1 += S1[p] * kk2; }
    const float sa0 = oct_sum(a0[0] + a0[1]), sa1 = oct_sum(a1[0] + a1[1]);
    const f32x2 n0 = {-sa0, -sa0}, n1 = {-sa1, -sa1}, v0 = {o.v[0], o.v[0]}, v1 = {o.v[1], o.v[1]};
    f32x2 y0 = {0.f, 0.f}, y1 = {0.f, 0.f};
#pragma unroll
    for (int p = 0; p < 4; ++p) {
        const int q = p >> 1, e = (p & 1) * 2;
        const f32x2 k2 = {o.k[q][e], o.k[q][e + 1]}, b2 = {o.b[q][e], o.b[q][e + 1]}, w2 = {o.w[q][e], o.w[q][e + 1]}, r2 = {o.r[q][e], o.r[q][e + 1]};
        S0[p] = S0[p] * w2 + (v0 * k2 + n0 * b2);
        S1[p] = S1[p] * w2 + (v1 * k2 + n1 * b2);
        y0 += S0[p] * r2; y1 += S1[p] * r2;
    }
    f32x2 y = {oct_sum(y0[0] + y0[1]), oct_sum(y1[0] + y1[1])};
    return y;
}
DEVINL void rw_stage(const bf16_t* rwbase, int t0, int hd, float* buf, int ht, int nth) {
    for (int item = ht; item < 7 * TC * 8; item += nth) {
        const int arr = item / (TC * 8), rem = item - arr * (TC * 8), tt = rem >> 3, c8 = rem & 7;
        const u32x4 raw = *(const u32x4*)(rwbase + (size_t)arr * T * 512 + (size_t)(t0 + tt) * 512 + hd * 64 + c8 * 8);
        f32x4 lo = {bflo(raw[0]), bfhi(raw[0]), bflo(raw[1]), bfhi(raw[1])}, hi = {bflo(raw[2]), bfhi(raw[2]), bflo(raw[3]), bfhi(raw[3])};
        if (arr == 1) {
#pragma unroll
            for (int j = 0; j < 4; ++j) { lo[j] = fexp2(lo[j]); hi[j] = fexp2(hi[j]); }
        }
        float* d = buf + arr * TC * 64 + tt * 64 + c8 * 8;
        *(f32x4*)d = lo; *(f32x4*)(d + 4) = hi;
    }
}
DEVINL void rw_stage_load(u32x4 (&raw)[4], const bf16_t* rwbase, int t0, int hd, int ht) {
    const int rem = ht & 127, tt = rem >> 3, c8 = rem & 7;
#pragma unroll
    for (int k = 0; k < 4; ++k) {
        const int arr = (ht >> 7) + 2 * k;
        if (arr < 7) raw[k] = *(const u32x4*)(rwbase + (size_t)arr * T * 512 + (size_t)(t0 + tt) * 512 + hd * 64 + c8 * 8);
    }
}
DEVINL void rw_stage_write(const u32x4 (&raw)[4], float* buf, int ht) {
    const int rem = ht & 127, tt = rem >> 3, c8 = rem & 7;
#pragma unroll
    for (int k = 0; k < 4; ++k) {
        const int arr = (ht >> 7) + 2 * k;
        if (arr < 7) {
            f32x4 lo = {bflo(raw[k][0]), bfhi(raw[k][0]), bflo(raw[k][1]), bfhi(raw[k][1])}, hi = {bflo(raw[k][2]), bfhi(raw[k][2]), bflo(raw[k][3]), bfhi(raw[k][3])};
            if (arr == 1) {
#pragma unroll
                for (int j = 0; j < 4; ++j) { lo[j] = fexp2(lo[j]); hi[j] = fexp2(hi[j]); }
            }
            float* d = buf + arr * TC * 64 + tt * 64 + c8 * 8;
            *(f32x4*)d = lo; *(f32x4*)(d + 4) = hi;
        }
    }
}
DEVINL void rw_wait_ready(const unsigned* cnt3, unsigned need, int nP) {
    for (int j = 0; j < nP; ++j)
        while (__hip_atomic_load(cnt3 + j, __ATOMIC_RELAXED, __HIP_MEMORY_SCOPE_AGENT) < need) __builtin_amdgcn_s_sleep(8);
    __builtin_amdgcn_fence(__ATOMIC_ACQUIRE, "agent");
    asm volatile("s_waitcnt vmcnt(0)" ::: "memory");
}
DEVINL void rwkv_scan(const Ctx& c, int layer, int b, int hd, const unsigned* cnt3, int nP, float* lds) {
    float* sy = lds + 3 * STG;
    const int tid = TID, lane = tid & 63, w = tid >> 6;
    const bf16_t* rwbase = c.RW();
    const bf16_t* GG = c.RW() + (size_t)6 * T * 512;
    bf16_t* Y = c.Y() + (size_t)2 * T * 512;
    const int rp = lane >> 3, jo = lane & 7, i0 = 16 * (w & 3) + 2 * rp;
    f32x2 S0[4], S1[4];
#pragma unroll
    for (int j = 0; j < 4; ++j) { S0[j] = (f32x2){0.f, 0.f}; S1[j] = (f32x2){0.f, 0.f}; }
    const float lng = c.in[I_LNG][layer * 512 + hd * 64 + lane], lnb = c.in[I_LNB][layer * 512 + hd * 64 + lane], rkv = c.in[I_RK][layer * 512 + hd * 64 + lane];
    __syncthreads();
    unsigned have = (unsigned)(layer * 16 + 1);
    rw_wait_ready(cnt3, have, nP);
    rw_stage(rwbase, b * L, hd, lds, tid, NTHR);
    u32x4 raw[4];
#pragma unroll
    for (int k = 0; k < 4; ++k) raw[k] = (u32x4){0u, 0u, 0u, 0u};
    if (w >= 4) rw_stage_load(raw, rwbase, b * L + TC, hd, tid - 256);
    __syncthreads();
    for (int ch = 0; ch <= NCH; ++ch) {
        if (w < 4) {
            if (ch < NCH) {
                const float* buf = lds + (ch % 3) * STG;
                float* syw = sy + (ch & 1) * TC * 64;
                RwOps ops[3];
                rw_load_ops(ops[0], buf, 0, jo, i0);
                rw_load_ops(ops[1], buf, 1, jo, i0);
#pragma unroll
                for (int tt = 0; tt < TC; ++tt) {
                    if (tt + 2 < TC) rw_load_ops(ops[(tt + 2) % 3], buf, tt + 2, jo, i0);
                    const f32x2 y = rw_step(S0, S1, ops[tt % 3]);
                    *(f32x2*)(syw + tt * 64 + i0) = y;
                }
            }
        } else {
            const int ht = tid - 256, hw = w - 4;
            if (ch + 1 < NCH) rw_stage_write(raw, lds + ((ch + 1) % 3) * STG, ht);
            if (ch + 2 < NCH) {
                const unsigned need = (unsigned)(layer * 16 + (ch + 2) / (7 * nP) + 1);
                if (need > have) { rw_wait_ready(cnt3, need, nP); have = need; }
                rw_stage_load(raw, rwbase, b * L + (ch + 2) * TC, hd, ht);
            }
            if (ch >= 1) {
                const int pc = ch - 1, t0 = b * L + pc * TC;
                const float* buf = lds + (pc % 3) * STG;
                const float* syr = sy + (pc & 1) * TC * 64;
#pragma unroll
                for (int k4 = 0; k4 < TC / 4; ++k4) {
                    const int tt = hw + 4 * k4, e = tt * 64 + lane;
                    const float y = syr[e];
                    const size_t idx = (size_t)(t0 + tt) * 512 + hd * 64 + lane;
                    const float gate = buf[6 * TC * 64 + e];
                    const float s1 = wave_sum_dpp(y), s2 = wave_sum_dpp(y * y), s3 = wave_sum_dpp(buf[e] * buf[2 * TC * 64 + e] * rkv);
                    const float mean = s1 * (1.f / 64.f);
                    const float var = fmaxf(s2 * (1.f / 64.f) - mean * mean, 0.f);
                    const float yn = (y - mean) * rsqrtf(var + 64e-5f) * lng + lnb;
                    Y[idx] = f2bf((yn + s3 * buf[3 * TC * 64 + e]) * gate);
                }
            }
        }
        __syncthreads();
    }
}


typedef float f32x4v __attribute__((ext_vector_type(4)));
#define MFMA16(a, b, c) __builtin_amdgcn_mfma_f32_16x16x32_bf16((a), (b), (c), 0, 0, 0)
constexpr int RP_KP = 296, RP_BW_BYTES = 64 * RP_KP * 2, RP_WAVE_BYTES = 16 * RP_KP * 2 + 16 * 192 * 2, RP_NW = 7, RP_NG = L / 16;
DEVINL float row16_sum(float v) { v += DPPF(v, 0xB1); v += DPPF(v, 0x4E); v += DPPF(v, 0x141); v += DPPF(v, 0x140); return v; }
DEVINL void rw_project_head(const Ctx& c, int layer, int b, int hd, int pj, int nP, unsigned* cnt, unsigned char* lds) {
    const int tid = TID, lane = tid & 63, w = tid >> 6, cl = lane & 15, kg = lane >> 4;
    bf16_t* BW = (bf16_t*)lds;
    bf16_t* ACT = (bf16_t*)(lds + RP_BW_BYTES + (w < RP_NW ? w : 0) * RP_WAVE_BYTES);
    bf16_t* RKV = ACT + 16 * RP_KP;
    const float* mu = c.in[I_MU] + layer * 1792;
    __syncthreads();
    {
        const float* w2 = c.in[I_W2] + (size_t)layer * 64 * 512 + hd * 64;
        const float* a2 = c.in[I_A2] + (size_t)layer * 64 * 512 + hd * 64;
        const float* g2 = c.in[I_G2] + (size_t)layer * 128 * 512 + hd * 64;
        const float* v2 = c.in[I_V2] + (size_t)(layer > 0 ? layer - 1 : 0) * 32 * 512 + hd * 64;
        for (int e = tid; e < 64 * 288; e += NTHR) {
            const int k = e >> 6, col = e & 63;
            float v;
            if (k < 64) v = w2[(size_t)k * 512 + col];
            else if (k < 128) v = a2[(size_t)(k - 64) * 512 + col];
            else if (k < 256) v = g2[(size_t)(k - 128) * 512 + col];
            else v = layer > 0 ? v2[(size_t)(k - 256) * 512 + col] : 0.f;
            BW[col * RP_KP + k] = f2bf(v);
        }
    }
    float w0c[4], a0c[4], kkc[4], kac[4], v0c[4];
#pragma unroll
    for (int nt = 0; nt < 4; ++nt) {
        const int col = layer * 512 + hd * 64 + nt * 16 + cl;
        w0c[nt] = c.in[I_W0][col]; a0c[nt] = c.in[I_A0][col]; kkc[nt] = c.in[I_KKW][col]; kac[nt] = c.in[I_KAW][col];
        v0c[nt] = layer > 0 ? c.in[I_V0][(layer - 1) * 512 + hd * 64 + nt * 16 + cl] : 0.f;
    }
    bf16_t* R = c.RW(); bf16_t* LD = c.RW() + (size_t)T * 512; bf16_t* KP = c.RW() + (size_t)2 * T * 512; bf16_t* VP = c.RW() + (size_t)3 * T * 512;
    bf16_t* KK = c.RW() + (size_t)4 * T * 512; bf16_t* BB = c.RW() + (size_t)5 * T * 512; bf16_t* GG = c.RW() + (size_t)6 * T * 512;
    const bf16_t* Zb = c.Z();
    int round = 0;
    for (int q0 = 0; nP * q0 + pj < RP_NG; q0 += RP_NW, ++round) {
        const int g = nP * (q0 + w) + pj;
        const bool act = (w < RP_NW) && (g < RP_NG);
        const int t0 = b * L + g * 16;
        __syncthreads();
        if (act) {
            {
                const int ch = lane & 31, par = lane >> 5, k = ch * 8;
                const f32x4 m0 = *(const f32x4*)(mu + 1536 + k), m1 = *(const f32x4*)(mu + 1536 + k + 4);
                const float fa = (ch < 8) ? 1.f : 0.f, fb = (ch < 8) ? -2.f : 1.f, fs = (ch < 8) ? 2.f * LOG2E : -LOG2E;
                const bool ident = (ch >= 8 && ch < 16);
                u32x4 cu[8], pr[8];
#pragma unroll
                for (int i = 0; i < 8; ++i) {
                    const int t = t0 + 2 * i + par;
                    cu[i] = *(const u32x4*)(Zb + (size_t)t * ZW + Z_C + 1536 + k);
                    pr[i] = (u32x4){0u, 0u, 0u, 0u};
                    if (t - b * L > 0) pr[i] = *(const u32x4*)(Zb + (size_t)(t - 1) * ZW + Z_C + 1536 + k);
                }
#pragma unroll
                for (int i = 0; i < 8; ++i) {
                    u32x4 o;
#pragma unroll
                    for (int j = 0; j < 4; ++j) {
                        const float c0 = bflo(cu[i][j]), c1 = bfhi(cu[i][j]), p0 = bflo(pr[i][j]), p1 = bfhi(pr[i][j]);
                        const float ma = (j < 2) ? m0[2 * j] : m1[2 * j - 4], mb = (j < 2) ? m0[2 * j + 1] : m1[2 * j - 3];
                        const float x0 = c0 + (p0 - c0) * ma, x1 = c1 + (p1 - c1) * mb;
                        const float y0 = fa + fb * __builtin_amdgcn_rcpf(1.f + fexp2(x0 * fs)), y1 = fa + fb * __builtin_amdgcn_rcpf(1.f + fexp2(x1 * fs));
                        o[j] = cvt_pk_bf16(ident ? x0 : y0, ident ? x1 : y1);
                    }
                    *(u32x4*)(ACT + (2 * i + par) * RP_KP + k) = o;
                }
                const int tokv = lane >> 2, kv = (lane & 3) * 8;
                *(u32x4*)(ACT + tokv * RP_KP + 256 + kv) = *(const u32x4*)(Zb + (size_t)(t0 + tokv) * ZW + Z_VL + kv);
            }
            {
                u32x4 cu[6], pr[6];
#pragma unroll
                for (int i = 0; i < 6; ++i) {
                    const int it = lane + 64 * i, tok = it / 24, rem = it - tok * 24, arr = rem >> 3, c8 = (rem & 7) * 8;
                    const int t = t0 + tok;
                    const int zcol = Z_C + arr * 512 + hd * 64 + c8;
                    cu[i] = *(const u32x4*)(Zb + (size_t)t * ZW + zcol);
                    pr[i] = (u32x4){0u, 0u, 0u, 0u};
                    if (t - b * L > 0) pr[i] = *(const u32x4*)(Zb + (size_t)(t - 1) * ZW + zcol);
                }
#pragma unroll
                for (int i = 0; i < 6; ++i) {
                    const int it = lane + 64 * i, tok = it / 24, rem = it - tok * 24, arr = rem >> 3, c8 = (rem & 7) * 8;
                    const f32x4 m0 = *(const f32x4*)(mu + arr * 512 + hd * 64 + c8), m1 = *(const f32x4*)(mu + arr * 512 + hd * 64 + c8 + 4);
                    u32x4 o;
#pragma unroll
                    for (int j = 0; j < 4; ++j) {
                        const float c0 = bflo(cu[i][j]), c1 = bfhi(cu[i][j]), p0 = bflo(pr[i][j]), p1 = bfhi(pr[i][j]);
                        const float ma = (j < 2) ? m0[2 * j] : m1[2 * j - 4], mb = (j < 2) ? m0[2 * j + 1] : m1[2 * j - 3];
                        o[j] = cvt_pk_bf16(c0 + (p0 - c0) * ma, c1 + (p1 - c1) * mb);
                    }
                    *(u32x4*)(RKV + tok * 192 + arr * 64 + c8) = o;
                }
            }
        }
        __syncthreads();
        if (act) {
            bf16x8 af[9];
#pragma unroll
            for (int ks = 0; ks < 9; ++ks) af[ks] = *(const bf16x8*)(ACT + cl * RP_KP + ks * 32 + kg * 8);
            float kkraw[4][4], av[4][4], ldv[4][4], gv[4][4], kmod[4][4], vout[4][4], rcv[4][4];
            float ss[4] = {0.f, 0.f, 0.f, 0.f};
#pragma unroll
            for (int nt = 0; nt < 4; ++nt) {
                const bf16_t* bp = BW + (nt * 16 + cl) * RP_KP + kg * 8;
                f32x4v aw = {0.f, 0.f, 0.f, 0.f}, aa = aw, ag = aw, avv = aw;
                aw = MFMA16(af[0], *(const bf16x8*)(bp), aw); aw = MFMA16(af[1], *(const bf16x8*)(bp + 32), aw);
                aa = MFMA16(af[2], *(const bf16x8*)(bp + 64), aa); aa = MFMA16(af[3], *(const bf16x8*)(bp + 96), aa);
#pragma unroll
                for (int ks = 4; ks < 8; ++ks) ag = MFMA16(af[ks], *(const bf16x8*)(bp + ks * 32), ag);
                avv = MFMA16(af[8], *(const bf16x8*)(bp + 256), avv);
#pragma unroll
                for (int rg = 0; rg < 4; ++rg) {
                    const int tk = kg * 4 + rg;
                    const bf16_t* rk = RKV + tk * 192 + nt * 16 + cl;
                    const float rc = bf2f(rk[0]), kc = bf2f(rk[64]), vc = bf2f(rk[128]);
                    const float u = -(w0c[nt] + aw[rg]);
                    const float spl = fmaxf(u, 0.f) + flog2(1.f + fexp2(-fabsf(u) * LOG2E)) * (1.f / LOG2E);
                    ldv[nt][rg] = -fexp2((-spl - 0.5f) * LOG2E) * LOG2E;
                    const float a = sigmoidf_(a0c[nt] + aa[rg]);
                    av[nt][rg] = a; gv[nt][rg] = ag[rg]; rcv[nt][rg] = rc;
                    const float kr = kc * kkc[nt];
                    kkraw[nt][rg] = kr; ss[rg] += kr * kr;
                    kmod[nt][rg] = kc * (1.f + (a - 1.f) * kac[nt]);
                    const size_t o = (size_t)(t0 + tk) * 512 + hd * 64 + nt * 16 + cl;
                    float vo = vc;
                    if (layer == 0) c.VF()[o] = f2bf(vc);
                    else { const float vf = bf2f(c.VF()[o]); vo = vc + (vf - vc) * sigmoidf_(v0c[nt] + avv[rg]); }
                    vout[nt][rg] = vo;
                }
            }
            float inv[4];
#pragma unroll
            for (int rg = 0; rg < 4; ++rg) inv[rg] = fminf(__builtin_amdgcn_rsqf(row16_sum(ss[rg])), 1e12f);
#pragma unroll
            for (int nt = 0; nt < 4; ++nt)
#pragma unroll
                for (int rg = 0; rg < 4; ++rg) {
                    const size_t o = (size_t)(t0 + kg * 4 + rg) * 512 + hd * 64 + nt * 16 + cl;
                    const float kk = kkraw[nt][rg] * inv[rg];
                    R[o] = f2bf(rcv[nt][rg]); LD[o] = f2bf(ldv[nt][rg]); KP[o] = f2bf(kmod[nt][rg]); VP[o] = f2bf(vout[nt][rg]);
                    KK[o] = f2bf(kk); BB[o] = f2bf(kk * av[nt][rg]); GG[o] = f2bf(gv[nt][rg]);
                }
        }
        asm volatile("s_waitcnt vmcnt(0)" ::: "memory");
        __syncthreads();
        if (threadIdx.x == 0) {
            __builtin_amdgcn_fence(__ATOMIC_RELEASE, "agent");
            __hip_atomic_store(cnt, (unsigned)(layer * 16 + round + 1), __ATOMIC_RELAXED, __HIP_MEMORY_SCOPE_AGENT);
        }
    }
    __syncthreads();
}

DEVINL void ret_block(const Ctx& c, int b, int hd, unsigned char* lds) {
    bf16_t* ST = (bf16_t*)lds;
    float* ssq = (float*)(lds + 128 * LROW);
    const int tid = TID, lane = tid & 63, w = tid >> 6, r = lane & 31, h = lane >> 5;
    const int qs = w & 3, dh = w >> 2, dvt = w >> 1, dt = w & 1;
    const float lg2 = flog2(1.f - fexp2(-5.f - (float)hd));
    const float gam = fexp2(lg2), gam128 = fexp2(lg2 * 128.f);
    f32x16 sacc;
#pragma unroll
    for (int i = 0; i < 16; ++i) sacc[i] = 0.f;
    const bf16_t* vtb = c.BVT() + (size_t)(b * 512 + hd * 128) * L;
    const bf16_t* ktb = c.BKT() + (size_t)(b * 256 + hd * 64) * L;
    bf16_t* Y = c.Y() + (size_t)T * 512;
    for (int ch = 0; ch < L / 128; ++ch) {
        const int t0 = b * L + ch * 128, p0 = ch * 128;
        __syncthreads();
#pragma unroll
        for (int i = 0; i < 16; ++i) {
            const int dv = dvt * 32 + (i & 3) + 8 * (i >> 2) + 4 * h;
            ST[dv * 72 + dt * 32 + r] = f2bf(sacc[i]);
        }
        __syncthreads();
        const int ql = qs * 32 + r;
        bf16x8 qf[4];
        const bf16_t* qp = c.Z() + (size_t)(t0 + ql) * ZW + Z_BQ + hd * 64 + 8 * h;
#pragma unroll
        for (int s = 0; s < 4; ++s) qf[s] = *(const bf16x8*)(qp + 16 * s);
        f32x16 o[2];
#pragma unroll
        for (int d = 0; d < 2; ++d) {
#pragma unroll
            for (int i = 0; i < 16; ++i) o[d][i] = 0.f;
#pragma unroll
            for (int s = 0; s < 4; ++s) {
                const bf16x8 sf = *(const bf16x8*)(ST + (dh * 64 + d * 32 + r) * 72 + 16 * s + 8 * h);
                o[d] = MFMA32(sf, qf[s], o[d]);
            }
#pragma unroll
            for (int i = 0; i < 16; ++i) o[d][i] *= gam;
        }
        for (int kt = 0; kt <= qs; ++kt) {
            const bf16_t* kp = c.Z() + (size_t)(t0 + kt * 32 + r) * ZW + Z_BK + hd * 64 + 8 * h;
            f32x16 st;
#pragma unroll
            for (int i = 0; i < 16; ++i) st[i] = 0.f;
#pragma unroll
            for (int s = 0; s < 4; ++s) { const bf16x8 kf = *(const bf16x8*)(kp + 16 * s); st = MFMA32(kf, qf[s], st); }
            bf16x8 pf[2];
#pragma unroll
            for (int s = 0; s < 2; ++s) {
                u32x4 pk;
#pragma unroll
                for (int jj = 0; jj < 4; ++jj) {
                    float a2[2];
#pragma unroll
                    for (int e = 0; e < 2; ++e) {
                        const int i = 8 * s + 2 * jj + e;
                        const int kl = kt * 32 + (i & 3) + 8 * (i >> 2) + 4 * h;
                        a2[e] = (kl <= ql) ? st[i] * fexp2(-lg2 * (float)kl) : 0.f;
                    }
                    pk[jj] = cvt_pk_bf16(a2[0], a2[1]);
                }
                pf[s] = __builtin_bit_cast(bf16x8, pk);
            }
#pragma unroll
            for (int d = 0; d < 2; ++d) {
                const bf16_t* vp = vtb + (size_t)(dh * 64 + d * 32 + r) * L + p0 + kt * 32 + 4 * h;
#pragma unroll
                for (int s = 0; s < 2; ++s) {
                    const u32x2 lo = *(const u32x2*)(vp + 16 * s), hi = *(const u32x2*)(vp + 16 * s + 8);
                    u32x4 vv = {lo[0], lo[1], hi[0], hi[1]};
                    o[d] = MFMA32(__builtin_bit_cast(bf16x8, vv), pf[s], o[d]);
                }
            }
        }
        const float gq = fexp2(lg2 * (float)ql);
        float ss = 0.f;
#pragma unroll
        for (int d = 0; d < 2; ++d)
#pragma unroll
            for (int i = 0; i < 16; ++i) { o[d][i] *= gq; ss += o[d][i] * o[d][i]; }
        ss += __shfl_xor(ss, 32);
        if (h == 0) ssq[dh * 128 + ql] = ss;
        __syncthreads();
        const float rs = rsqrtf((ssq[ql] + ssq[128 + ql]) * (1.f / 128.f) + 1e-6f);
        {
            const bf16_t* gp = c.Z() + (size_t)(t0 + ql) * ZW + Z_BG + hd * 128 + dh * 64;
            bf16_t* yp = Y + (size_t)(t0 + ql) * 512 + hd * 128 + dh * 64;
#pragma unroll
            for (int d = 0; d < 2; ++d)
#pragma unroll
                for (int g = 0; g < 4; ++g) {
                    const int dl = d * 32 + 8 * g + 4 * h;
                    const u32x2 gg = *(const u32x2*)(gp + dl);
                    float gv[4] = {bflo(gg[0]), bfhi(gg[0]), bflo(gg[1]), bfhi(gg[1])};
                    float ov[4];
#pragma unroll
                    for (int j = 0; j < 4; ++j) { const float sg = gv[j] * sigmoidf_(gv[j]); ov[j] = sg * o[d][4 * g + j] * rs; }
                    u32x2 pk; pk[0] = cvt_pk_bf16(ov[0], ov[1]); pk[1] = cvt_pk_bf16(ov[2], ov[3]);
                    *(u32x2*)(yp + dl) = pk;
                }
        }
#pragma unroll
        for (int i = 0; i < 16; ++i) sacc[i] *= gam128;
        {
            const bf16_t* va = vtb + (size_t)(dvt * 32 + r) * L + p0 + 8 * h;
            const bf16_t* kb = ktb + (size_t)(dt * 32 + r) * L + p0 + 8 * h;
#pragma unroll 2
            for (int ks = 0; ks < 8; ++ks) {
                const bf16x8 vf = *(const bf16x8*)(va + 16 * ks);
                const u32x4 kr = *(const u32x4*)(kb + 16 * ks);
                u32x4 kd;
#pragma unroll
                for (int jj = 0; jj < 4; ++jj) {
                    const int j0 = 16 * ks + 8 * h + 2 * jj;
                    kd[jj] = cvt_pk_bf16(bflo(kr[jj]) * fexp2(lg2 * (float)(127 - j0)), bfhi(kr[jj]) * fexp2(lg2 * (float)(126 - j0)));
                }
                sacc = MFMA32(vf, __builtin_bit_cast(bf16x8, kd), sacc);
            }
        }
    }
}

DEVINL void sb_task(const Ctx& c, int b, int hd, int qg) {
    const int lane = TID & 63, r = lane & 31, h = lane >> 5;
    const int q0 = qg * 32;
    bf16_t* yp = c.Y() + (size_t)(b * L + q0 + r) * 512 + hd * 64;
    if (qg < 3) {
        u32x2 z = {0u, 0u};
#pragma unroll
        for (int d = 0; d < 2; ++d)
#pragma unroll
            for (int g = 0; g < 4; ++g) *(u32x2*)(yp + d * 32 + 8 * g + 4 * h) = z;
        return;
    }
    const bf16_t* zb = c.Z() + (size_t)b * L * ZW;
    bf16x8 qf[4];
    {
        const bf16_t* qp = zb + (size_t)(q0 + r) * ZW + Z_AQ + hd * 64 + 8 * h;
#pragma unroll
        for (int s = 0; s < 4; ++s) qf[s] = *(const bf16x8*)(qp + 16 * s);
    }
    f32x16 o[2];
#pragma unroll
    for (int d = 0; d < 2; ++d)
#pragma unroll
        for (int i = 0; i < 16; ++i) o[d][i] = 0.f;
    float carry = 0.f;
    const int qpos = q0 + r;
    const bf16_t* vtb = c.AVT() + (size_t)(b * 512 + hd * 64 + r) * L + 4 * h;
    bf16x8 kfn[4], vfn[2][2], kfm[4], vfm[2][2];
#define SB_LOAD(KF, VF, KT) do { const int k0_ = (KT) * 32; const bf16_t* kp_ = zb + (size_t)(k0_ + r) * ZW + Z_AK + hd * 64 + 8 * h; \
        _Pragma("unroll") for (int s_ = 0; s_ < 4; ++s_) KF[s_] = *(const bf16x8*)(kp_ + 16 * s_); \
        _Pragma("unroll") for (int d_ = 0; d_ < 2; ++d_) _Pragma("unroll") for (int s_ = 0; s_ < 2; ++s_) { \
            const bf16_t* vp_ = vtb + (size_t)(d_ * 32) * L + k0_ + 16 * s_; const u32x2 lo_ = *(const u32x2*)(vp_), hi_ = *(const u32x2*)(vp_ + 8); \
            u32x4 vv_ = {lo_[0], lo_[1], hi_[0], hi_[1]}; VF[d_][s_] = __builtin_bit_cast(bf16x8, vv_); } } while (0)
    SB_LOAD(kfn, vfn, qg);
    SB_LOAD(kfm, vfm, (qg > 3 ? qg - 1 : 3));
    for (int kt = qg; kt >= 3; --kt) {
        const int k0 = kt * 32;
        bf16x8 kf[4], vf[2][2];
#pragma unroll
        for (int s = 0; s < 4; ++s) { kf[s] = kfn[s]; kfn[s] = kfm[s]; }
#pragma unroll
        for (int d = 0; d < 2; ++d)
#pragma unroll
            for (int s = 0; s < 2; ++s) { vf[d][s] = vfn[d][s]; vfn[d][s] = vfm[d][s]; }
        SB_LOAD(kfm, vfm, (kt > 4 ? kt - 2 : 3));
        f32x16 st;
#pragma unroll
        for (int i = 0; i < 16; ++i) st[i] = 0.f;
#pragma unroll
        for (int s = 0; s < 4; ++s) st = MFMA32(kf[s], qf[s], st);
        const bool boundary = (kt == qg) || (kt == 3);
        float x[16], ls[16];
#pragma unroll
        for (int i = 0; i < 16; ++i) {
            const float z = st[i];
            const float sp = fmaxf(z, 0.f) + flog2(1.f + fexp2(-fabsf(z)));
            const int key = k0 + (i & 3) + 8 * (i >> 2) + 4 * h;
            const bool ok = !boundary || (key < qpos && key >= 112);
            x[i] = ok ? -sp : 0.f;
            ls[i] = ok ? z - sp : -INFINITY;
        }
        float og[4], tot[4];
#pragma unroll
        for (int g = 0; g < 4; ++g) {
            const float gs = (x[4 * g] + x[4 * g + 1]) + (x[4 * g + 2] + x[4 * g + 3]);
            og[g] = __shfl_xor(gs, 32);
            tot[g] = gs + og[g];
        }
        float suf[4];
        suf[3] = 0.f; suf[2] = tot[3]; suf[1] = suf[2] + tot[2]; suf[0] = suf[1] + tot[1];
        float a[16];
#pragma unroll
        for (int g = 0; g < 4; ++g) {
            float af = carry + suf[g] + (h == 0 ? og[g] : 0.f);
            a[4 * g + 3] = fexp2(ls[4 * g + 3] + af); af += x[4 * g + 3];
            a[4 * g + 2] = fexp2(ls[4 * g + 2] + af); af += x[4 * g + 2];
            a[4 * g + 1] = fexp2(ls[4 * g + 1] + af); af += x[4 * g + 1];
            a[4 * g + 0] = fexp2(ls[4 * g + 0] + af);
        }
        carry += (tot[0] + tot[1]) + (tot[2] + tot[3]);
        const bool sb_done = __all(carry < -80.f);
#pragma unroll
        for (int s = 0; s < 2; ++s) {
            u32x4 pk;
#pragma unroll
            for (int jj = 0; jj < 4; ++jj) pk[jj] = cvt_pk_bf16(a[8 * s + 2 * jj], a[8 * s + 2 * jj + 1]);
            const bf16x8 pf = __builtin_bit_cast(bf16x8, pk);
            o[0] = MFMA32(vf[0][s], pf, o[0]);
            o[1] = MFMA32(vf[1][s], pf, o[1]);
        }
        if (sb_done) break;
    }
#pragma unroll
    for (int d = 0; d < 2; ++d)
#pragma unroll
        for (int g = 0; g < 4; ++g) {
            u32x2 pk; pk[0] = cvt_pk_bf16(o[d][4 * g], o[d][4 * g + 1]); pk[1] = cvt_pk_bf16(o[d][4 * g + 2], o[d][4 * g + 3]);
            *(u32x2*)(yp + d * 32 + 8 * g + 4 * h) = pk;
        }
}

DEVINL void swa_task(const Ctx& c, int layer, int b, int qh, int qg) {
    const int lane = TID & 63, r = lane & 31, h = lane >> 5;
    const int q0 = qg * 32, kvh = qh >> 2;
    bf16_t* yp = c.Y() + (size_t)3 * T * 512 + (size_t)(b * L + q0 + r) * 512 + qh * 64;
    if (qg < 3) {
        u32x2 z = {0u, 0u};
#pragma unroll
        for (int d = 0; d < 2; ++d)
#pragma unroll
            for (int g = 0; g < 4; ++g) *(u32x2*)(yp + d * 32 + 8 * g + 4 * h) = z;
        return;
    }
    const bf16_t* zb = c.Z() + (size_t)b * L * ZW;
    bf16x8 qf[4];
    {
        const bf16_t* qp = zb + (size_t)(q0 + r) * ZW + Z_DQ + qh * 64 + 8 * h;
#pragma unroll
        for (int s = 0; s < 4; ++s) qf[s] = *(const bf16x8*)(qp + 16 * s);
    }
    f32x16 o[2];
#pragma unroll
    for (int d = 0; d < 2; ++d)
#pragma unroll
        for (int i = 0; i < 16; ++i) o[d][i] = 0.f;
    const float slope2 = fexp2(-(float)(qh + 1)) * LOG2E;
    float mrun = c.in[I_SINK][layer * 8 + qh] * LOG2E, lrun = 1.f;
    const int qpos = q0 + r;
    const bf16_t* vtb = c.DVT() + (size_t)(b * 128 + kvh * 64 + r) * L + 4 * h;
    const int kt_lo = (qg - 4) > 4 ? (qg - 4) : 4;
    const int ntiles = 1 + (qg >= 4 ? (qg - kt_lo + 1) : 0);
    bf16x8 kfn[4], vfn[2][2];
#define SWA_LOAD(KT) do { const int k0_ = (KT) * 32; const bf16_t* kp_ = zb + (size_t)(k0_ + r) * ZW + Z_DK + kvh * 64 + 8 * h; \
        _Pragma("unroll") for (int s_ = 0; s_ < 4; ++s_) kfn[s_] = *(const bf16x8*)(kp_ + 16 * s_); \
        _Pragma("unroll") for (int d_ = 0; d_ < 2; ++d_) _Pragma("unroll") for (int s_ = 0; s_ < 2; ++s_) { \
            const bf16_t* vp_ = vtb + (size_t)(d_ * 32) * L + k0_ + 16 * s_; const u32x2 lo_ = *(const u32x2*)(vp_), hi_ = *(const u32x2*)(vp_ + 8); \
            u32x4 vv_ = {lo_[0], lo_[1], hi_[0], hi_[1]}; vfn[d_][s_] = __builtin_bit_cast(bf16x8, vv_); } } while (0)
    SWA_LOAD(3);
    for (int it = 0; it < ntiles; ++it) {
        const bool meta = (it == 0);
        const int kt = meta ? 3 : (kt_lo + it - 1);
        const int k0 = kt * 32;
        bf16x8 kf[4], vf[2][2];
#pragma unroll
        for (int s = 0; s < 4; ++s) kf[s] = kfn[s];
#pragma unroll
        for (int d = 0; d < 2; ++d)
#pragma unroll
            for (int s = 0; s < 2; ++s) vf[d][s] = vfn[d][s];
        { const int nk = (it + 1 < ntiles) ? (kt_lo + it) : kt; SWA_LOAD(nk); }
        f32x16 st;
#pragma unroll
        for (int i = 0; i < 16; ++i) st[i] = 0.f;
#pragma unroll
        for (int s = 0; s < 4; ++s) st = MFMA32(kf[s], qf[s], st);
        float sc[16]; float tmax = -INFINITY;
#pragma unroll
        for (int i = 0; i < 16; ++i) {
            const int key = k0 + (i & 3) + 8 * (i >> 2) + 4 * h;
            const int dist = qpos - key;
            const bool ok = meta ? (key >= 112 && dist >= 0) : (dist >= 0 && dist < 128);
            const float v = meta ? st[i] : st[i] - slope2 * (float)dist;
            sc[i] = ok ? v : -INFINITY;
            tmax = fmaxf(tmax, sc[i]);
        }
        tmax = fmaxf(tmax, __shfl_xor(tmax, 32));
        const float mnew = fmaxf(mrun, tmax);
        const float alpha = fexp2(mrun - mnew);
        float psum = 0.f; float pv[16];
#pragma unroll
        for (int i = 0; i < 16; ++i) { pv[i] = fexp2(sc[i] - mnew); psum += pv[i]; }
        psum += __shfl_xor(psum, 32);
        lrun = lrun * alpha + psum; mrun = mnew;
#pragma unroll
        for (int d = 0; d < 2; ++d)
#pragma unroll
            for (int i = 0; i < 16; ++i) o[d][i] *= alpha;
#pragma unroll
        for (int s = 0; s < 2; ++s) {
            u32x4 pk;
#pragma unroll
            for (int jj = 0; jj < 4; ++jj) pk[jj] = cvt_pk_bf16(pv[8 * s + 2 * jj], pv[8 * s + 2 * jj + 1]);
            const bf16x8 pf = __builtin_bit_cast(bf16x8, pk);
            o[0] = MFMA32(vf[0][s], pf, o[0]);
            o[1] = MFMA32(vf[1][s], pf, o[1]);
        }
    }
    const float inv = __builtin_amdgcn_rcpf(lrun);
#pragma unroll
    for (int d = 0; d < 2; ++d)
#pragma unroll
        for (int g = 0; g < 4; ++g) {
            u32x2 pk; pk[0] = cvt_pk_bf16(o[d][4 * g] * inv, o[d][4 * g + 1] * inv); pk[1] = cvt_pk_bf16(o[d][4 * g + 2] * inv, o[d][4 * g + 3] * inv);
            *(u32x2*)(yp + d * 32 + 8 * g + 4 * h) = pk;
        }
}

DEVINL void group_barrier(unsigned* word, unsigned target) {
    asm volatile("s_waitcnt vmcnt(0) lgkmcnt(0)" ::: "memory");
    __syncthreads();
    if (threadIdx.x == 0) {
        __builtin_amdgcn_fence(__ATOMIC_RELEASE, "agent");
        __hip_atomic_fetch_add(word, 1u, __ATOMIC_RELAXED, __HIP_MEMORY_SCOPE_AGENT);
        while (__hip_atomic_load(word, __ATOMIC_RELAXED, __HIP_MEMORY_SCOPE_AGENT) < target) __builtin_amdgcn_s_sleep(2);
        __builtin_amdgcn_fence(__ATOMIC_ACQUIRE, "agent");
        asm volatile("s_waitcnt vmcnt(0)" ::: "memory");
    }
    __syncthreads();
}
DEVINL void partial_merge(const Ctx& c, unsigned char* lds, int idx, int nblk);
DEVINL void phase_mixers(const Ctx& c, int layer, unsigned char* lds) {
    const int bx = BID, G = gridDim.x;
    unsigned* cnts = (unsigned*)(c.ws + WS_END + 1024);
    if (bx < 64) { rwkv_scan(c, layer, bx >> 3, bx & 7, cnts + bx * 3, bx < 32 ? 3 : 2, (float*)lds); return; }
    if (bx < 96) ret_block(c, (bx - 64) >> 2, (bx - 64) & 3, lds);
    else {
        if (bx < 256) {
            const int idx = bx - 96;
            int head, pj, nP;
            if (idx < 96) { head = idx / 3; pj = idx - head * 3; nP = 3; } else { const int j = idx - 96; head = 32 + (j >> 1); pj = j & 1; nP = 2; }
            rw_project_head(c, layer, head >> 3, head & 7, pj, nP, cnts + head * 3 + pj, lds);
        }
        const int nw = (G - 96) * (NTHR / 64), wid = (bx - 96) * (NTHR / 64) + (TID >> 6);
        const int NSB = 68 * 64;
        for (int i = wid; i < 2 * NSB; i += nw) {
            if (i < NSB) { const int qg = 67 - i / 64, bh = i & 63; sb_task(c, bh >> 3, bh & 7, qg); }
            else { const int i2 = i - NSB; const int qg = 67 - i2 / 64, bh = i2 & 63; swa_task(c, layer, bh >> 3, bh & 7, qg); }
        }
    }
    group_barrier((unsigned*)(c.ws + WS_END + 768), (unsigned)((layer + 1) * (G - 64)));
    partial_merge(c, lds, bx - 64, G - 64);
}

DEVINL float* mp_row(const Ctx& c, int t) { return (float*)(c.Z() + (size_t)t * ZW); }
template <int NI, int MODE>
DEVINL void merge_tile(const Ctx& c, unsigned char* lds, int m0, int n0) {
    const int lane = TID & 63, w = TID >> 6, wm = w & 3, wn = w >> 2, r = lane & 31, h = lane >> 5;
    f32x16 mer[NI][2]; zero_acc(mer);
    const int mbase = m0 + wm * 64, nbase = n0 + wn * 32 * NI;
#pragma unroll 1
    for (int bi = 0; bi < (MODE == 0 ? 3 : 1); ++bi) {
        const int br = (MODE == 0) ? (bi == 2 ? 3 : bi) : 2;
        f32x16 acc[NI][2]; zero_acc(acc);
        gemm_kloop<NI>(c.Y() + (size_t)br * T * 512, 512, c.Pbr() + (size_t)br * DM * 512, 512, 512, m0, n0, lds, acc);
#pragma unroll
        for (int mi = 0; mi < 2; ++mi) {
            const bf16_t* gp = c.Z() + (size_t)(mbase + mi * 32 + r) * ZW + Z_GZ + br * DM + nbase;
#pragma unroll
            for (int ni = 0; ni < NI; ++ni)
#pragma unroll
                for (int g = 0; g < 4; ++g) {
                    const u32x2 gg = *(const u32x2*)(gp + ni * 32 + 8 * g + 4 * h);
                    mer[ni][mi][4 * g + 0] += bflo(gg[0]) * acc[ni][mi][4 * g + 0];
                    mer[ni][mi][4 * g + 1] += bfhi(gg[0]) * acc[ni][mi][4 * g + 1];
                    mer[ni][mi][4 * g + 2] += bflo(gg[1]) * acc[ni][mi][4 * g + 2];
                    mer[ni][mi][4 * g + 3] += bfhi(gg[1]) * acc[ni][mi][4 * g + 3];
                }
        }
    }
    if (MODE == 0) {
#pragma unroll
        for (int mi = 0; mi < 2; ++mi) {
            float* pp = mp_row(c, mbase + mi * 32 + r) + nbase;
#pragma unroll
            for (int ni = 0; ni < NI; ++ni)
#pragma unroll
                for (int g = 0; g < 4; ++g) {
                    f32x4 v = {mer[ni][mi][4 * g], mer[ni][mi][4 * g + 1], mer[ni][mi][4 * g + 2], mer[ni][mi][4 * g + 3]};
                    *(f32x4*)(pp + ni * 32 + 8 * g + 4 * h) = v;
                }
        }
        return;
    }
#pragma unroll
    for (int mi = 0; mi < 2; ++mi) {
        const float* pp = mp_row(c, mbase + mi * 32 + r) + nbase;
#pragma unroll
        for (int ni = 0; ni < NI; ++ni)
#pragma unroll
            for (int g = 0; g < 4; ++g) {
                const f32x4 v = *(const f32x4*)(pp + ni * 32 + 8 * g + 4 * h);
#pragma unroll
                for (int j = 0; j < 4; ++j) mer[ni][mi][4 * g + j] += v[j];
            }
    }
    if (NI == 2) {
        u32x2 pkm[2][2][4];
#pragma unroll
        for (int mi = 0; mi < 2; ++mi)
#pragma unroll
            for (int ni = 0; ni < 2; ++ni)
#pragma unroll
                for (int g = 0; g < 4; ++g) { pkm[mi][ni][g][0] = cvt_pk_bf16(mer[ni % NI][mi][4 * g], mer[ni % NI][mi][4 * g + 1]); pkm[mi][ni][g][1] = cvt_pk_bf16(mer[ni % NI][mi][4 * g + 2], mer[ni % NI][mi][4 * g + 3]); }
        store_rows_via_lds(lds, pkm, c.M() + (size_t)mbase * DM + nbase, DM);
    } else {
#pragma unroll
        for (int mi = 0; mi < 2; ++mi) {
            bf16_t* mp = c.M() + (size_t)(mbase + mi * 32 + r) * DM + nbase;
#pragma unroll
            for (int g = 0; g < 4; ++g) {
                u32x2 pk; pk[0] = cvt_pk_bf16(mer[0][mi][4 * g], mer[0][mi][4 * g + 1]); pk[1] = cvt_pk_bf16(mer[0][mi][4 * g + 2], mer[0][mi][4 * g + 3]);
                *(u32x2*)(mp + 8 * g + 4 * h) = pk;
            }
        }
    }
}
DEVINL void partial_merge(const Ctx& c, unsigned char* lds, int idx, int nblk) {
    const int MT = T / 256, NT = DM / 128, total = MT * NT;
    if ((nblk & 7) == 0 && NT == 8) {
        const int x = idx & 7, local = idx >> 3, per = nblk >> 3;
        for (int j = local; ; j += per) {
            const int tm = x + 8 * (j >> 3), tn = j & 7;
            if (tm >= MT) break;
            merge_tile<2, 0>(c, lds, tm * 256, tn * 128);
        }
        return;
    }
    for (int q = idx; q < total; q += nblk) {
        int tm, tn; tile_of(q, MT, NT, tm, tn);
        merge_tile<2, 0>(c, lds, tm * 256, tn * 128);
    }
}
DEVINL void phase_merge(const Ctx& c, unsigned char* lds) {
    const int MT = T / 256, NT = DM / 128, total = MT * NT, G = gridDim.x, slot = slot_of_block();
    const int nfull = (total / G) * G, rem = total - nfull;
    const bool halves = rem > 0 && 2 * rem <= G;
    for (int q = slot; q < (halves ? nfull : total); q += G) {
        int tm, tn; tile_of(q, MT, NT, tm, tn);
        merge_tile<2, 1>(c, lds, tm * 256, tn * 128);
    }
    if (halves && slot < 2 * rem) {
        int tm, tn; tile_of(nfull + (slot >> 1), MT, NT, tm, tn);
        merge_tile<1, 1>(c, lds, tm * 256, tn * 128 + (slot & 1) * 64);
    }
}

template <int NI>
DEVINL void resid_tile(const Ctx& c, const bf16_t* A, int K, const bf16_t* Bt, unsigned char* lds, int m0, int n0, bool dostore) {
    const int lane = TID & 63, w = TID >> 6, wm = w & 3, wn = w >> 2, r = lane & 31, h = lane >> 5;
    f32x16 acc[NI][2]; zero_acc(acc);
    gemm_kloop<NI>(A, K, Bt, K, K, m0, n0, lds, acc);
    const int mbase = m0 + wm * 64, nbase = n0 + wn * 32 * NI;
#pragma unroll
    for (int mi = 0; mi < 2; ++mi) {
        float* xp = xrow(c, mbase + mi * 32 + r) + nbase;
#pragma unroll
        for (int ni = 0; ni < NI; ++ni)
#pragma unroll
            for (int g = 0; g < 4; ++g) {
                f32x4 v = *(f32x4*)(xp + ni * 32 + 8 * g + 4 * h);
#pragma unroll
                for (int j = 0; j < 4; ++j) v[j] += acc[ni][mi][4 * g + j];
                if (dostore || v[0] != v[0]) *(f32x4*)(xp + ni * 32 + 8 * g + 4 * h) = v;
            }
    }
}
DEVINL void phase_gemm_resid(const Ctx& c, const bf16_t* A, int K, const bf16_t* Bt, unsigned char* lds, bool dostore = true) {
    const int MT = T / 256, NT = DM / 128, total = MT * NT, G = gridDim.x, slot = slot_of_block();
    const int nfull = (total / G) * G, rem = total - nfull;
    const bool halves = rem > 0 && 2 * rem <= G;
    for (int q = slot; q < (halves ? nfull : total); q += G) {
        int tm, tn; tile_of(q, MT, NT, tm, tn);
        resid_tile<2>(c, A, K, Bt, lds, tm * 256, tn * 128, dostore);
    }
    if (halves && slot < 2 * rem) {
        int tm, tn; tile_of(nfull + (slot >> 1), MT, NT, tm, tn);
        resid_tile<1>(c, A, K, Bt, lds, tm * 256, tn * 128 + (slot & 1) * 64, dostore);
    }
}

DEVINL void phase_up(const Ctx& c, unsigned char* lds) {
    const int MT = T / 256, NT = DFF / 128, total = MT * NT, G = gridDim.x, slot = slot_of_block();
    const int lane = TID & 63, w = TID >> 6, wm = w & 3, wn = w >> 2, r = lane & 31, h = lane >> 5;
    const int nfull = (total / G) * G, rem = total - nfull;
    const bool halves = rem > 0 && 2 * rem <= G;
    if (halves && slot < 2 * rem) {
        int tm, tn; tile_of(nfull + (slot >> 1), MT, NT, tm, tn);
        const int n0 = tn * 128 + (slot & 1) * 64;
        f32x16 acc1[1][2]; zero_acc(acc1);
        gemm_kloop<1>(c.H(), DM, c.Wup(), DM, DM, tm * 256, n0, lds, acc1);
        const int mbase = tm * 256 + wm * 64, nb = n0 + wn * 32;
#pragma unroll
        for (int mi = 0; mi < 2; ++mi) {
            bf16_t* up = c.U() + (size_t)(mbase + mi * 32 + r) * DFF + nb;
#pragma unroll
            for (int g = 0; g < 4; ++g) {
                float v[4];
#pragma unroll
                for (int j = 0; j < 4; ++j) { const float a = fmaxf(acc1[0][mi][4 * g + j], 0.f); v[j] = a * a; }
                u32x2 o; o[0] = cvt_pk_bf16(v[0], v[1]); o[1] = cvt_pk_bf16(v[2], v[3]);
                *(u32x2*)(up + 8 * g + 4 * h) = o;
            }
        }
    }
    for (int q = slot; q < (halves ? nfull : total); q += G) {
        int tm, tn; tile_of(q, MT, NT, tm, tn);
        f32x16 acc[2][2]; zero_acc(acc);
        gemm_kloop(c.H(), DM, c.Wup(), DM, DM, tm * 256, tn * 128, lds, acc);
        const int mbase = tm * 256 + wm * 64, nbase = tn * 128 + wn * 64;
        {
            u32x2 pku[2][2][4];
#pragma unroll
            for (int mi = 0; mi < 2; ++mi)
#pragma unroll
                for (int ni = 0; ni < 2; ++ni)
#pragma unroll
                    for (int g = 0; g < 4; ++g) {
                        float v[4];
#pragma unroll
                        for (int j = 0; j < 4; ++j) { const float a = fmaxf(acc[ni][mi][4 * g + j], 0.f); v[j] = a * a; }
                        pku[mi][ni][g][0] = cvt_pk_bf16(v[0], v[1]); pku[mi][ni][g][1] = cvt_pk_bf16(v[2], v[3]);
                    }
            store_rows_via_lds(lds, pku, c.U() + (size_t)mbase * DFF + nbase, DFF);
        }
    }
}

DEVINL void grid_barrier(unsigned* bar, unsigned epoch) {
    asm volatile("s_waitcnt vmcnt(0) lgkmcnt(0)" ::: "memory");
    __syncthreads();
    if (threadIdx.x == 0) {
        __builtin_amdgcn_fence(__ATOMIC_RELEASE, "agent");
        const unsigned G = gridDim.x;
        if ((G & 7u) == 0u) {
            const unsigned g = blockIdx.x & 7u, ng = G >> 3;
            const unsigned old = __hip_atomic_fetch_add(bar + 16 * (1 + g), 1u, __ATOMIC_RELAXED, __HIP_MEMORY_SCOPE_AGENT);
            if (old + 1u == epoch * ng) __hip_atomic_fetch_add(bar, 1u, __ATOMIC_RELAXED, __HIP_MEMORY_SCOPE_AGENT);
            while (__hip_atomic_load(bar, __ATOMIC_RELAXED, __HIP_MEMORY_SCOPE_AGENT) < epoch * 8u) __builtin_amdgcn_s_sleep(0);
        } else {
            __hip_atomic_fetch_add(bar, 1u, __ATOMIC_RELAXED, __HIP_MEMORY_SCOPE_AGENT);
            while (__hip_atomic_load(bar, __ATOMIC_RELAXED, __HIP_MEMORY_SCOPE_AGENT) < epoch * G) __builtin_amdgcn_s_sleep(0);
        }
        __builtin_amdgcn_fence(__ATOMIC_ACQUIRE, "agent");
        asm volatile("s_waitcnt vmcnt(0)" ::: "memory");
    }
    __syncthreads();
}

constexpr int LDS_BYTES = 3 * STAGE;
constexpr int PH_PER_LAYER = 8, N_PHASES = 1 + DEPTH * PH_PER_LAYER;

__global__ void __launch_bounds__(NTHR) fwd_megakernel(Params P) {
    extern __shared__ __attribute__((aligned(16))) unsigned char lds[];
    cg::grid_group grid = cg::this_grid();
    Ctx c;
    c.in = P.in; c.ws = P.ws; c.out = P.out;
    const int lo = P.ph_lo, hi = P.ph_hi;
    unsigned epoch = 0;
    if (hi < 0) grid.sync();
    for (int ph = lo; ph < hi; ++ph) {
        if (ph == 0) phase_init(c);
        else {
            const int layer = (ph - 1) / PH_PER_LAYER, sub = (ph - 1) % PH_PER_LAYER;
#ifdef PROBE_SUB
#define PROBE_LAST (rep == ((sub == PROBE_SUB || PROBE_SUB == 99) ? 1 : 0))
            for (int rep = 0; rep < ((sub == PROBE_SUB || PROBE_SUB == 99) ? 2 : 1); ++rep)
#else
#define PROBE_LAST true
#endif
            switch (sub) {
                case 0: phase_norm(c, c.in[I_N1G] + layer * DM, true); phase_cvt(c, layer, (float*)lds); break;
                case 1:
#ifdef PROBE_TRIV
                    phase_inproj(c, layer, lds, true);
#endif
                    phase_inproj(c, layer, lds); break;
                case 2: phase_mixers(c, layer, lds); break;
                case 3: phase_merge(c, lds); break;
                case 4: phase_gemm_resid(c, c.M(), DM, c.Wo(), lds, PROBE_LAST); break;
                case 5: phase_norm(c, c.in[I_N2G] + layer * DM, false); break;
                case 6: phase_up(c, lds); break;
                case 7: phase_gemm_resid(c, c.U(), DFF, c.Wdn(), lds, PROBE_LAST); break;
            }
        }
        if (ph + 1 < hi) {
#if MULTI_LAUNCH
            grid.sync();
#else
#ifdef PROBE_BAR
            for (int rb = 0; rb < PROBE_BAR; ++rb) grid_barrier((unsigned*)(c.ws + WS_END), ++epoch);
#endif
            grid_barrier((unsigned*)(c.ws + WS_END), ++epoch);
#endif
        }
    }
}

extern "C" void kernel_launch(void* const* d_in, const int* in_sizes, int n_in, void* d_out, int out_size, void* d_ws, size_t ws_size, hipStream_t stream) {
    static int grid_blocks = 0;
    if (!grid_blocks) {
        int dev = 0, cus = 0, per_cu = 0;
        hipGetDevice(&dev);
        hipDeviceGetAttribute(&cus, hipDeviceAttributeMultiprocessorCount, dev);
        hipFuncSetAttribute((const void*)fwd_megakernel, hipFuncAttributeMaxDynamicSharedMemorySize, LDS_BYTES);
        hipOccupancyMaxActiveBlocksPerMultiprocessor(&per_cu, (const void*)fwd_megakernel, NTHR, LDS_BYTES);
        if (per_cu < 1) per_cu = 1;
        grid_blocks = cus * per_cu;
        if (grid_blocks > 256) grid_blocks = 256;
        if (ws_size < WS_END) fprintf(stderr, "kernel_launch: workspace too small: %zu < %zu\n", ws_size, (size_t)WS_END);
        if (n_in != N_INPUTS) fprintf(stderr, "kernel_launch: expected %d inputs, got %d\n", (int)N_INPUTS, n_in);
    }
    Params p{};
    for (int i = 0; i < N_INPUTS; ++i) p.in[i] = (const float*)d_in[i];
    p.out = (float*)d_out; p.ws = (unsigned char*)d_ws;
#if MULTI_LAUNCH
    for (int ph = 0; ph < N_PHASES; ++ph) {
        p.ph_lo = ph; p.ph_hi = ph + 1;
        hipLaunchKernelGGL(fwd_megakernel, dim3(grid_blocks), dim3(NTHR), LDS_BYTES, stream, p);
    }
#else
    p.ph_lo = 0; p.ph_hi = N_PHASES;
    hipMemsetAsync((unsigned char*)d_ws + WS_END, 0, 2048, stream);
    void* args[] = {&p};
    hipError_t e = hipLaunchCooperativeKernel((const void*)fwd_megakernel, dim3(grid_blocks), dim3(NTHR), args, LDS_BYTES, stream);
    if (e != hipSuccess) fprintf(stderr, "cooperative launch failed: %s (grid %d)\n", hipGetErrorString(e), grid_blocks);
#endif
}
```
